# Optimizing an MI355X kernel written in HIP

```python
import jax, jax.numpy as jnp
from jax import lax
import numpy as np

D_MODEL = 2048
BATCH = 4
SEQ = 2048
DEPTH = 2
DEC_BATCH = 128
DEC_SEQ = 1
PAST_LEN = 16384
PAGE_SIZE = 128

MIX_WIDTH = D_MODEL
W_A = MIX_WIDTH // 2
H_A = 8
HD_A = W_A // H_A
K_A = 4
LRU_C = 8.0
W_B = MIX_WIDTH // 4
K_B = 31
W_C = MIX_WIDTH // 4
H_C = 4
HD_C = W_C // H_C
CHUNK = 128
D_IN = 2 * (W_A + W_B + W_C)
D_FF = 4 * D_MODEL
EPS = 1e-6

kernel_name = "hybrid_rglru_convmod_chunkmlp_decode"


def rms_norm(x, g):
    x32 = x.astype(jnp.float32)
    y = x32 * lax.rsqrt(jnp.mean(x32 * x32, axis=-1, keepdims=True) + EPS)
    return (y * g.astype(jnp.float32)).astype(x.dtype)


def layer_norm(x, g, b):
    x32 = x.astype(jnp.float32)
    xc = x32 - jnp.mean(x32, axis=-1, keepdims=True)
    y = xc * lax.rsqrt(jnp.mean(xc * xc, axis=-1, keepdims=True) + EPS)
    return (y * g.astype(jnp.float32) + b.astype(jnp.float32)).astype(x.dtype)


def causal_dwconv(x_full, w):
    c = x_full.shape[-1]
    return lax.conv_general_dilated(
        x_full, w.astype(x_full.dtype)[:, None, :], window_strides=(1,), padding='VALID',
        dimension_numbers=('NWC', 'WIO', 'NWC'), feature_group_count=c)


def rg_lru(x, h0, w_r, b_r, w_i, b_i, lam):
    bsz, seq_len, _ = x.shape
    xh = x.reshape(bsz, seq_len, H_A, HD_A)
    r = jax.nn.sigmoid(jnp.einsum('blhi,hij->blhj', xh, w_r.astype(x.dtype)).reshape(bsz, seq_len, W_A).astype(jnp.float32) + b_r.astype(jnp.float32))
    i = jax.nn.sigmoid(jnp.einsum('blhi,hij->blhj', xh, w_i.astype(x.dtype)).reshape(bsz, seq_len, W_A).astype(jnp.float32) + b_i.astype(jnp.float32))
    log_a = -LRU_C * r * jax.nn.softplus(-lam.astype(jnp.float32))
    a = jnp.exp(log_a)
    u = jnp.sqrt(-jnp.expm1(2.0 * log_a)) * (i * x.astype(jnp.float32))

    def step(h, au):
        a_t, u_t = au
        h = a_t * h + u_t
        return h, h

    h_last, hs = lax.scan(step, h0.astype(jnp.float32), (jnp.swapaxes(a, 0, 1), jnp.swapaxes(u, 0, 1)))
    return jnp.swapaxes(hs, 0, 1).astype(x.dtype), h_last


def spatial_gate(u, v, w_s, b_s):
    bsz, seq_len, _ = v.shape
    pad = (-seq_len) % CHUNK
    vp = jnp.pad(v, ((0, 0), (0, pad), (0, 0)))
    n_chunks = (seq_len + pad) // CHUNK
    vr = vp.reshape(bsz, n_chunks, CHUNK, H_C, HD_C)
    mask = jnp.tril(jnp.ones((CHUNK, CHUNK), dtype=w_s.dtype))
    w = (w_s * mask[None]).astype(v.dtype)
    mixed = jnp.einsum('hts,bcshd->bcthd', w, vr) + b_s.T.astype(v.dtype)[None, None, :, :, None]
    mixed = mixed.reshape(bsz, n_chunks * CHUNK, W_C)[:, :seq_len]
    return u * mixed


def hybrid_layer(x, conv_a_buf, h0, conv_b_buf, p, l):
    hn = rms_norm(x, p['norm_mix'][l])
    z = jnp.einsum('bld,de->ble', hn, p['w_in'][l].astype(x.dtype))
    xa, ga, xb, gb, zc = jnp.split(z, [W_A, 2 * W_A, 2 * W_A + W_B, 2 * W_A + 2 * W_B], axis=-1)
    xa_full = jnp.concatenate([conv_a_buf.astype(x.dtype), xa], axis=1)
    xa_conv = causal_dwconv(xa_full, p['conv_a_w'][l]) + p['conv_a_b'][l].astype(x.dtype)
    y_a, h_last = rg_lru(xa_conv, h0, p['gate_r_w'][l], p['gate_r_b'][l], p['gate_i_w'][l], p['gate_i_b'][l], p['lru_lambda'][l])
    y_a = y_a * jax.nn.gelu(ga)
    ub = xb * jax.nn.sigmoid(gb)
    ub_full = jnp.concatenate([conv_b_buf.astype(x.dtype), ub], axis=1)
    y_b = causal_dwconv(ub_full, p['conv_b_w'][l])
    y_b = jax.nn.silu(layer_norm(y_b, p['ln_b_g'][l], p['ln_b_b'][l]))
    uc, vc = jnp.split(jax.nn.gelu(zc), 2, axis=-1)
    vn = layer_norm(vc, p['sgu_ln_g'][l], p['sgu_ln_b'][l])
    y_c = spatial_gate(uc, vn, p['sgu_w'][l], p['sgu_b'][l])
    mix = jnp.concatenate([y_a, y_b, y_c], axis=-1)
    x = x + jnp.einsum('blm,md->bld', mix, p['w_out'][l].astype(x.dtype))
    hf = rms_norm(x, p['norm_ffn'][l])
    ff = jnp.square(jax.nn.relu(jnp.einsum('bld,df->blf', hf, p['w_ff1'][l].astype(x.dtype))))
    x = x + jnp.einsum('blf,fd->bld', ff, p['w_ff2'][l].astype(x.dtype))
    return x, xa_full[:, -(K_A - 1):], h_last, ub_full[:, -(K_B - 1):], vn


def trunk(x, conv_a_bufs, h0s, conv_b_bufs, p):
    ca, hh, cb, vv = [], [], [], []
    for l in range(DEPTH):
        x, c_a, h_l, c_b, v_l = hybrid_layer(x, conv_a_bufs[l], h0s[l], conv_b_bufs[l], p, l)
        ca.append(c_a)
        hh.append(h_l)
        cb.append(c_b)
        vv.append(v_l)
    y = rms_norm(x, p['norm_final'])
    return y, jnp.stack(ca), jnp.stack(hh), jnp.stack(cb), jnp.stack(vv)


def setup_inputs(seed: int = 0) -> dict:
    key = jax.random.key(seed)
    ks = jax.random.split(key, 32)
    f32 = jnp.float32

    def nrm(k, shape, s):
        return jax.random.normal(k, shape, f32) * s

    p_a = jax.random.uniform(ks[10], (DEPTH, W_A), f32, minval=0.9, maxval=0.999)
    a0 = p_a ** (1.0 / LRU_C)
    lru_lambda = jnp.log(a0) - jnp.log1p(-a0)
    return {
        'x_prompt': nrm(ks[0], (BATCH, SEQ, D_MODEL), 1.0),
        'x_sample': nrm(ks[1], (DEC_BATCH, DEC_SEQ, D_MODEL), 1.0),
        'state_conv_a': nrm(ks[2], (DEPTH, DEC_BATCH, K_A - 1, W_A), 1.0),
        'state_lru_h': nrm(ks[3], (DEPTH, DEC_BATCH, W_A), 0.5),
        'state_conv_b': nrm(ks[4], (DEPTH, DEC_BATCH, K_B - 1, W_B), 1.0),
        'norm_mix': 1.0 + nrm(ks[5], (DEPTH, D_MODEL), 0.02),
        'w_in': nrm(ks[6], (DEPTH, D_MODEL, D_IN), D_MODEL ** -0.5),
        'conv_a_w': nrm(ks[7], (DEPTH, K_A, W_A), K_A ** -0.5),
        'conv_a_b': nrm(ks[8], (DEPTH, W_A), 0.01),
        'gate_r_w': nrm(ks[9], (DEPTH, H_A, HD_A, HD_A), HD_A ** -0.5),
        'gate_r_b': nrm(ks[11], (DEPTH, W_A), 0.01),
        'gate_i_w': nrm(ks[12], (DEPTH, H_A, HD_A, HD_A), HD_A ** -0.5),
        'gate_i_b': nrm(ks[13], (DEPTH, W_A), 0.01),
        'lru_lambda': lru_lambda,
        'conv_b_w': nrm(ks[14], (DEPTH, K_B, W_B), K_B ** -0.5),
        'ln_b_g': 1.0 + nrm(ks[15], (DEPTH, W_B), 0.02),
        'ln_b_b': nrm(ks[16], (DEPTH, W_B), 0.01),
        'sgu_ln_g': 1.0 + nrm(ks[17], (DEPTH, W_C), 0.02),
        'sgu_ln_b': nrm(ks[18], (DEPTH, W_C), 0.01),
        'sgu_w': nrm(ks[19], (DEPTH, H_C, CHUNK, CHUNK), CHUNK ** -0.5),
        'sgu_b': 1.0 + nrm(ks[20], (DEPTH, H_C, CHUNK), 0.02),
        'w_out': nrm(ks[21], (DEPTH, MIX_WIDTH, D_MODEL), MIX_WIDTH ** -0.5),
        'norm_ffn': 1.0 + nrm(ks[22], (DEPTH, D_MODEL), 0.02),
        'w_ff1': nrm(ks[23], (DEPTH, D_MODEL, D_FF), D_MODEL ** -0.5),
        'w_ff2': nrm(ks[24], (DEPTH, D_FF, D_MODEL), D_FF ** -0.5),
        'norm_final': 1.0 + nrm(ks[25], (D_MODEL,), 0.02),
    }


def reference(x_prompt, x_sample, state_conv_a, state_lru_h, state_conv_b,
              norm_mix, w_in, conv_a_w, conv_a_b, gate_r_w, gate_r_b, gate_i_w, gate_i_b,
              lru_lambda, conv_b_w, ln_b_g, ln_b_b, sgu_ln_g, sgu_ln_b, sgu_w, sgu_b,
              w_out, norm_ffn, w_ff1, w_ff2, norm_final):
    p = dict(norm_mix=norm_mix, w_in=w_in, conv_a_w=conv_a_w, conv_a_b=conv_a_b,
             gate_r_w=gate_r_w, gate_r_b=gate_r_b, gate_i_w=gate_i_w, gate_i_b=gate_i_b,
             lru_lambda=lru_lambda, conv_b_w=conv_b_w, ln_b_g=ln_b_g, ln_b_b=ln_b_b,
             sgu_ln_g=sgu_ln_g, sgu_ln_b=sgu_ln_b, sgu_w=sgu_w, sgu_b=sgu_b,
             w_out=w_out, norm_ffn=norm_ffn, w_ff1=w_ff1, w_ff2=w_ff2, norm_final=norm_final)
    nb = x_prompt.shape[0]
    zero_ca = jnp.zeros((DEPTH, nb, K_A - 1, W_A), x_prompt.dtype)
    zero_h = jnp.zeros((DEPTH, nb, W_A), jnp.float32)
    zero_cb = jnp.zeros((DEPTH, nb, K_B - 1, W_B), x_prompt.dtype)
    y_prompt, ca_p, h_p, cb_p, _ = trunk(x_prompt, zero_ca, zero_h, zero_cb, p)
    y_sample, ca_s, h_s, cb_s, v_s = trunk(x_sample, state_conv_a, state_lru_h, state_conv_b, p)
    return (y_prompt, y_sample, ca_p, h_p, cb_p, ca_s, h_s, cb_s, v_s)
```

```cpp
#include <hip/hip_runtime.h>
#include <hip/hip_cooperative_groups.h>
#include <cstdio>
#include <cstdint>
namespace cg = cooperative_groups;

namespace pg8 {
#define PG8_LAS __attribute__((address_space(3)))
typedef unsigned short bf16_t;
typedef short bf16x8 __attribute__((ext_vector_type(8)));
typedef float f32x4 __attribute__((ext_vector_type(4)));
typedef unsigned u32x4 __attribute__((ext_vector_type(4)));
constexpr int BM = 256, BK = 64, HALF = 128, HTB = HALF * BK * 2  , STAGE_BYTES = 8 * HTB, NXCD = 8, WGM = 8;

__host__ __device__ __forceinline__ int lds_byte(int r, int c) { const int st = (r >> 4) * 2 + (c >> 5), rr = r & 15, cc = c & 31, ob = rr * 64 + cc * 2; return st * 1024 + (ob ^ (((ob >> 9) & 1) << 5)); }
__host__ __device__ __forceinline__ void stage_rc(int b, int& R, int& C) { const int st = b / 1024, sb = b % 1024, swz = sb ^ (((sb >> 9) & 1) << 5); R = (st >> 1) * 16 + swz / 64; C = (st & 1) * 32 + (swz % 64) / 2; }
__host__ __device__ __forceinline__ int perm32(int rho) { const int n = rho >> 4, i = rho & 15; return 8 * (i >> 2) + 4 * n + (i & 3); }

struct Unit { int pm, pn; };
struct Gemm { const bf16_t* A; const bf16_t* Bt; int M, N, K; };

struct StaticOrder {
    int nM, nN, nwg, G, c, wgm;
    __host__ __device__ void init(int M, int N, int G_, int c_, int wgm_ = WGM) { nM = M / BM; nN = N / BM; nwg = nM * nN; G = G_; c = c_; wgm = wgm_; }
    __host__ __device__ bool next(int i, Unit& u) const {
        const long L = (long)i * G + c; if (L >= nwg) return false;
        int wgid = (int)L; { const int q = nwg / NXCD, r = nwg % NXCD, xcd = wgid % NXCD, off = wgid / NXCD; wgid = (xcd < r ? xcd * (q + 1) : r * (q + 1) + (xcd - r) * q) + off; }
        const int nig = wgm * nN, gid = wgid / nig, fm = gid * wgm, gsz = (nM - fm) < wgm ? (nM - fm) : wgm;
        u.pm = fm + ((wgid % nig) % gsz); u.pn = (wgid % nig) / gsz; return true;
    }
    __device__ __forceinline__ void a_ready(const Unit&) const {}
    __device__ __forceinline__ void done(const Unit&) const {}
};

__device__ __forceinline__ unsigned cvt_pk_bf16(float lo, float hi) { unsigned r; asm volatile("v_cvt_pk_bf16_f32 %0, %1, %2" : "=v"(r) : "v"(lo), "v"(hi)); return r; }

template <int ACT  > struct EpiBf16 {
    static constexpr bool PERM = true, AFTER_DRAIN = false;
    bf16_t* O; int ldc; const float* rss; float inv_k, eps;
    __device__ __forceinline__ void operator()(const f32x4 (&acc)[2][2][4][2], const Unit& u, int wr, int wc, int fr, int fq) const {
        const int row0 = u.pm * BM + wr * 64 + fr; const int col0 = u.pn * BM + wc * 32 + 8 * fq;
        float rs[2][4];
#pragma unroll
        for (int ai = 0; ai < 2; ++ai)
#pragma unroll
            for (int m = 0; m < 4; ++m) rs[ai][m] = rss[row0 + ai * HALF + m * 16];
        __builtin_amdgcn_sched_barrier(0);
#pragma unroll
        for (int ai = 0; ai < 2; ++ai)
#pragma unroll
            for (int m = 0; m < 4; ++m) { bf16_t* rowp = O + (size_t)(row0 + ai * HALF + m * 16) * ldc + col0;
                const float rstd = __builtin_amdgcn_rsqf(rs[ai][m] * inv_k + eps);
#pragma unroll
                for (int bj = 0; bj < 2; ++bj) { f32x4 v0 = acc[ai][bj][m][0] * rstd, v1 = acc[ai][bj][m][1] * rstd;
                    if (ACT == 2) {
#pragma unroll
                        for (int e = 0; e < 4; ++e) { float a = fmaxf(v0[e], 0.f), b = fmaxf(v1[e], 0.f); v0[e] = a * a; v1[e] = b * b; } }
                    u32x4 w; w.x = cvt_pk_bf16(v0[0], v0[1]); w.y = cvt_pk_bf16(v0[2], v0[3]); w.z = cvt_pk_bf16(v1[0], v1[1]); w.w = cvt_pk_bf16(v1[2], v1[3]);
                    *(u32x4*)(rowp + bj * HALF) = w; } }
    }
};
typedef unsigned u32x2_t __attribute__((ext_vector_type(2)));
struct EpiResF32 {
    static constexpr bool PERM = false, AFTER_DRAIN = false;
    const float* base; float* out; int ldc; bf16_t* xb; float* rss;
    __device__ __forceinline__ void operator()(const f32x4 (&acc)[2][2][4][2], const Unit& u, int wr, int wc, int fr, int fq) const {
        const int col0 = u.pn * BM + wc * 32 + 4 * fq;
#pragma unroll
        for (int ai = 0; ai < 2; ++ai) {
            f32x4 bs[4][2][2];
#pragma unroll
            for (int m = 0; m < 4; ++m) { const float* b = base + (size_t)(u.pm * BM + ai * HALF + wr * 64 + m * 16 + fr) * ldc + col0;
#pragma unroll
                for (int bj = 0; bj < 2; ++bj)
#pragma unroll
                    for (int n = 0; n < 2; ++n) bs[m][bj][n] = *(const f32x4*)(b + bj * HALF + n * 16); }
            __builtin_amdgcn_sched_barrier(0);
#pragma unroll
            for (int m = 0; m < 4; ++m) { const int r = u.pm * BM + ai * HALF + wr * 64 + m * 16 + fr; float* o = out + (size_t)r * ldc + col0; float ss = 0.f;
#pragma unroll
                for (int bj = 0; bj < 2; ++bj)
#pragma unroll
                    for (int n = 0; n < 2; ++n) { const f32x4 v = bs[m][bj][n] + acc[ai][bj][m][n]; *(f32x4*)(o + bj * HALF + n * 16) = v;
                        if (xb) { u32x2_t w; w.x = cvt_pk_bf16(v[0], v[1]); w.y = cvt_pk_bf16(v[2], v[3]); *(u32x2_t*)(xb + (size_t)r * ldc + col0 + bj * HALF + n * 16) = w; ss += (v[0] * v[0] + v[1] * v[1]) + (v[2] * v[2] + v[3] * v[3]); } }
                if (xb) { ss += __shfl_xor(ss, 16); ss += __shfl_xor(ss, 32); if (fq == 0) atomicAdd(rss + r, ss); } }
            __builtin_amdgcn_sched_barrier(0);
        }
    }
};

template <class Epi, class Sched, bool ALIGN_EPI = false, bool SP2 = false>
__device__ __forceinline__ void gemm_phase(PG8_LAS unsigned char* lds, const Gemm g, const Sched& S, const Epi& E) {
    int tid_ = threadIdx.x; asm volatile("" : "+v"(tid_));
    const int tid = tid_, wid = __builtin_amdgcn_readfirstlane(tid >> 6), lane = tid & 63, wr = wid >> 2, wc = wid & 3, fr = lane & 15, fq = lane >> 4;
    const int K = g.K, nt = K / BK;
    unsigned voffA[2], voffB[2];
#pragma unroll
    for (int i = 0; i < 2; ++i) { int R, C; stage_rc(tid * 16 + i * 8192, R, C); const int Rb = Epi::PERM ? ((R & ~31) + perm32(R & 31)) : R;
        voffA[i] = (unsigned)(R * K + C) * 2u; voffB[i] = (unsigned)(Rb * K + C) * 2u; }
    const size_t kstep = (size_t)(BK * 2);
    const size_t hstep = (size_t)HALF * K * 2;
    const size_t tstep = 2 * hstep;
    const unsigned ldsw = (unsigned)wid * 1024u;
    const int aoff = lds_byte(wr * 64 + fr, fq * 8), boff = lds_byte(wc * 32 + fr, fq * 8);
#define PG8_SA(b, h) (((b) * 2 + (h)) * HTB)
#define PG8_SB(b, h) ((4 + (b) * 2 + (h)) * HTB)
#define PG8_STAGE(bufoff, gbase, voff) do { _Pragma("unroll") for (int _i = 0; _i < 2; ++_i) \
        __builtin_amdgcn_global_load_lds((const unsigned*)((const char*)(gbase) + (voff)[_i]), (PG8_LAS unsigned*)(lds + (bufoff) + ldsw + _i * 8192), 16, 0, 0); } while (0)
#define PG8_LDA(dst, b, h) do { _Pragma("unroll") for (int m = 0; m < 4; ++m) _Pragma("unroll") for (int k = 0; k < 2; ++k) dst[m][k] = *(const PG8_LAS bf16x8*)(lds + PG8_SA(b, h) + aoff + m * 2048 + k * 1024); } while (0)
#define PG8_LDB(dst, b, h) do { _Pragma("unroll") for (int n = 0; n < 2; ++n) _Pragma("unroll") for (int k = 0; k < 2; ++k) dst[n][k] = *(const PG8_LAS bf16x8*)(lds + PG8_SB(b, h) + boff + n * 2048 + k * 1024); } while (0)
#define PG8_MMA(ai, bj, At, Bt) do { __builtin_amdgcn_s_setprio(1); _Pragma("unroll") for (int m = 0; m < 4; ++m) _Pragma("unroll") for (int n = 0; n < 2; ++n) _Pragma("unroll") for (int k = 0; k < 2; ++k) \
        acc[ai][bj][m][n] = __builtin_amdgcn_mfma_f32_16x16x32_bf16(Bt[n][k], At[m][k], acc[ai][bj][m][n], 0, 0, 0); __builtin_amdgcn_s_setprio(0); } while (0)
#define PG8_WAIT_V(n) asm volatile("s_waitcnt vmcnt(" #n ")" ::: "memory")
#define PG8_WAIT_L(n) asm volatile("s_waitcnt lgkmcnt(" #n ")" ::: "memory")
#define PG8_BAR __builtin_amdgcn_s_barrier()
#define PG8_SCHED __builtin_amdgcn_sched_barrier(0)
    Unit cur, nxt; int ui = 0;
    if (!S.next(0, cur)) return;
    f32x4 acc[2][2][4][2];
#pragma unroll
    for (int a = 0; a < 2; ++a)
#pragma unroll
        for (int b = 0; b < 2; ++b)
#pragma unroll
            for (int m = 0; m < 4; ++m)
#pragma unroll
                for (int n = 0; n < 2; ++n) acc[a][b][m][n] = (f32x4){0.f, 0.f, 0.f, 0.f};
    bf16x8 At[4][2], B0[2][2], B1[2][2];
    const char* cA = (const char*)g.A + (size_t)cur.pm * tstep; const char* cB = (const char*)g.Bt + (size_t)cur.pn * tstep;
    S.a_ready(cur);
    if constexpr (SP2) {
        PG8_STAGE(PG8_SB(0, 0), cB, voffB); PG8_STAGE(PG8_SB(0, 1), cB + hstep, voffB); PG8_STAGE(PG8_SA(0, 0), cA, voffA); PG8_STAGE(PG8_SA(0, 1), cA + hstep, voffA);
        if (wr == 1) PG8_BAR;
        PG8_WAIT_V(2); PG8_BAR;
        PG8_STAGE(PG8_SB(1, 0), cB + kstep, voffB); PG8_STAGE(PG8_SA(1, 0), cA + kstep, voffA); PG8_STAGE(PG8_SB(1, 1), cB + hstep + kstep, voffB);
        PG8_WAIT_V(6); PG8_BAR;
    } else {
        PG8_STAGE(PG8_SB(0, 0), cB, voffB); PG8_STAGE(PG8_SA(0, 0), cA, voffA); PG8_STAGE(PG8_SB(0, 1), cB + hstep, voffB); PG8_STAGE(PG8_SA(0, 1), cA + hstep, voffA);
        if (wr == 1) PG8_BAR;
        PG8_WAIT_V(4); PG8_BAR;
        PG8_STAGE(PG8_SB(1, 0), cB + kstep, voffB); PG8_STAGE(PG8_SA(1, 0), cA + kstep, voffA); PG8_STAGE(PG8_SB(1, 1), cB + hstep + kstep, voffB);
        PG8_WAIT_V(6); PG8_BAR;
    }
    for (;;) {
        const bool has_next = S.next(ui + 1, nxt);
        const char* nA = has_next ? (const char*)g.A + (size_t)nxt.pm * tstep : cA; const char* nB = has_next ? (const char*)g.Bt + (size_t)nxt.pn * tstep : cB;
        for (int t = 0; t < nt; t += 2) {
            const bool last = (t == nt - 2);
            const char* a1 = cA + (size_t)(t + 1) * kstep;
            const char* a2 = last ? nA : cA + (size_t)(t + 2) * kstep; const char* b2 = last ? nB : cB + (size_t)(t + 2) * kstep;
            const char* a3 = a2 + kstep; const char* b3 = b2 + kstep;
            if (last && has_next) S.a_ready(nxt);
            if constexpr (SP2) {
            PG8_LDB(B0, 0, 0); PG8_LDB(B1, 0, 1); PG8_SCHED; PG8_LDA(At, 0, 0); PG8_STAGE(PG8_SA(1, 1), a1 + hstep, voffA);
            PG8_WAIT_V(8); PG8_WAIT_L(0); PG8_BAR; PG8_MMA(0, 0, At, B0); PG8_MMA(0, 1, At, B1); PG8_BAR; PG8_SCHED;
            PG8_LDA(At, 0, 1); PG8_STAGE(PG8_SB(0, 0), b2, voffB); PG8_STAGE(PG8_SB(0, 1), b2 + hstep, voffB); PG8_STAGE(PG8_SA(0, 0), a2, voffA);
            PG8_WAIT_V(8); PG8_WAIT_L(0); PG8_BAR; PG8_MMA(1, 0, At, B0); PG8_MMA(1, 1, At, B1); PG8_BAR; PG8_SCHED;
            PG8_LDB(B0, 1, 0); PG8_LDB(B1, 1, 1); PG8_SCHED; PG8_LDA(At, 1, 0); PG8_STAGE(PG8_SA(0, 1), a2 + hstep, voffA);
            PG8_WAIT_V(8); PG8_WAIT_L(0); PG8_BAR; PG8_MMA(0, 0, At, B0); PG8_MMA(0, 1, At, B1); PG8_BAR; PG8_SCHED;
            PG8_LDA(At, 1, 1); PG8_STAGE(PG8_SB(1, 0), b3, voffB); PG8_STAGE(PG8_SB(1, 1), b3 + hstep, voffB); PG8_STAGE(PG8_SA(1, 0), a3, voffA);
            PG8_WAIT_V(8); PG8_WAIT_L(0); PG8_BAR; PG8_MMA(1, 0, At, B0); PG8_MMA(1, 1, At, B1); PG8_BAR; PG8_SCHED;
            } else {
            PG8_LDB(B0, 0, 0); PG8_SCHED; PG8_LDA(At, 0, 0); PG8_STAGE(PG8_SA(1, 1), a1 + hstep, voffA);
            PG8_WAIT_L(8); PG8_BAR; PG8_WAIT_L(0); PG8_MMA(0, 0, At, B0); PG8_BAR; PG8_SCHED;
            PG8_LDB(B1, 0, 1); PG8_STAGE(PG8_SB(0, 0), b2, voffB);
            PG8_BAR; PG8_WAIT_L(0); PG8_MMA(0, 1, At, B1); PG8_BAR;
            PG8_LDA(At, 0, 1); PG8_STAGE(PG8_SA(0, 0), a2, voffA);
            PG8_BAR; PG8_WAIT_L(0); PG8_MMA(1, 0, At, B0); PG8_BAR; PG8_SCHED;
            PG8_STAGE(PG8_SB(0, 1), b2 + hstep, voffB);
            PG8_WAIT_V(6); PG8_BAR; PG8_MMA(1, 1, At, B1); PG8_BAR;
            PG8_LDB(B0, 1, 0); PG8_SCHED; PG8_LDA(At, 1, 0); PG8_STAGE(PG8_SA(0, 1), a2 + hstep, voffA);
            PG8_WAIT_L(8); PG8_BAR; PG8_WAIT_L(0); PG8_MMA(0, 0, At, B0); PG8_BAR; PG8_SCHED;
            PG8_LDB(B1, 1, 1); PG8_STAGE(PG8_SB(1, 0), b3, voffB);
            PG8_BAR; PG8_WAIT_L(0); PG8_MMA(0, 1, At, B1); PG8_BAR;
            PG8_LDA(At, 1, 1); PG8_STAGE(PG8_SA(1, 0), a3, voffA);
            PG8_BAR; PG8_WAIT_L(0); PG8_MMA(1, 0, At, B0); PG8_BAR; PG8_SCHED;
            PG8_STAGE(PG8_SB(1, 1), b3 + hstep, voffB);
            PG8_WAIT_V(6); PG8_BAR; PG8_MMA(1, 1, At, B1); PG8_BAR;
            }
        }
        if constexpr (ALIGN_EPI) { if (wr == 0) PG8_BAR; }
        if constexpr (!Epi::AFTER_DRAIN) { E(acc, cur, wr, wc, fr, fq); S.done(cur); }
        if (!has_next) break;
#pragma unroll
        for (int a = 0; a < 2; ++a)
#pragma unroll
            for (int b = 0; b < 2; ++b)
#pragma unroll
                for (int m = 0; m < 4; ++m)
#pragma unroll
                    for (int n = 0; n < 2; ++n) acc[a][b][m][n] = (f32x4){0.f, 0.f, 0.f, 0.f};
        cur = nxt; cA = nA; cB = nB; ++ui;
        if constexpr (ALIGN_EPI) { if (wr == 1) PG8_BAR; }
    }
    PG8_WAIT_V(0);
    if constexpr (!ALIGN_EPI) { if (wr == 0) PG8_BAR; }
    PG8_BAR;
    if constexpr (Epi::AFTER_DRAIN) { E.fused(acc, cur, wr, wc, fr, fq, lds, wid, lane); S.done(cur); }
#undef PG8_SA
#undef PG8_SB
#undef PG8_STAGE
#undef PG8_LDA
#undef PG8_LDB
#undef PG8_MMA
#undef PG8_WAIT_V
#undef PG8_WAIT_L
#undef PG8_BAR
#undef PG8_SCHED
}
}

#define LAS __attribute__((address_space(3)))
typedef unsigned short bf16_t;
typedef short bf16x8 __attribute__((ext_vector_type(8)));
typedef float f32x4 __attribute__((ext_vector_type(4)));
typedef unsigned u32x4 __attribute__((ext_vector_type(4)));
typedef unsigned u32x2 __attribute__((ext_vector_type(2)));

constexpr int DM = 2048, NB = 4, SEQ = 2048, DEPTH = 2, NS = 128;
constexpr int MPROMPT = NB * SEQ, MV = MPROMPT + NS, MPAD = 8448;
constexpr int WA = 1024, WB = 512, WC = 512, KB = 31;
constexpr int DIN = 4096, DFF = 8192;
constexpr int ZXA = 0, ZGA = 1024, ZXB = 2048, ZGB = 2560, ZUC = 3072, ZVC = 3584;
constexpr int MYA = 0, MYB = 1024, MYC = 1536;
constexpr float EPS = 1e-6f;
constexpr size_t O_YP = 0, O_YS = 16777216, O_CAP = O_YS + 262144, O_HP = O_CAP + 24576, O_CBP = O_HP + 8192, O_CAS = O_CBP + 122880,
                 O_HS = O_CAS + 786432, O_CBS = O_HS + 262144, O_VS = O_CBS + 3932160;
enum { I_XP = 0, I_XS, I_SCA, I_SH, I_SCB, I_NMIX, I_WIN, I_CAW, I_CAB, I_GRW, I_GRB, I_GIW, I_GIB, I_LAM, I_CBW, I_LNBG, I_LNBB, I_SLG, I_SLB, I_SW, I_SB, I_WOUT, I_NFFN, I_WFF1, I_WFF2, I_NFIN, N_INPUTS };
constexpr size_t MiB = 1u << 20;
constexpr size_t WS_WIN = 1 * MiB, WS_WOUT = 33 * MiB, WS_WFF1 = 49 * MiB, WS_WFF2 = 113 * MiB, WS_GATE = 177 * MiB, WS_SGUW = 178 * MiB, WS_CARRY = 179 * MiB;
constexpr size_t WS_X = 180 * MiB, WS_HN = 246 * MiB, WS_Z = 279 * MiB, WS_MIX = 345 * MiB, WS_HLOC = 378 * MiB, WS_PCUM = 394 * MiB, WS_FF = 279 * MiB, WS_PART = 411 * MiB, WS_END = 419 * MiB, WS_QCTR = 16384, WS_RS = 65536;
constexpr int LDS_BYTES = 147456;

struct Args { const float* in[N_INPUTS]; float* out; unsigned char* ws; int ph_lo, ph_hi; };

__device__ __forceinline__ unsigned f2bf(float f) { unsigned u = __builtin_bit_cast(unsigned, f); return (u + 0x7fffu + ((u >> 16) & 1u)) >> 16; }
__device__ __forceinline__ unsigned pk2(float lo, float hi) { unsigned r; asm("v_cvt_pk_bf16_f32 %0, %1, %2" : "=v"(r) : "v"(lo), "v"(hi)); return r; }
__device__ __forceinline__ float bflo(unsigned w) { return __builtin_bit_cast(float, w << 16); }
__device__ __forceinline__ float bfhi(unsigned w) { return __builtin_bit_cast(float, w & 0xffff0000u); }
__device__ __forceinline__ float bf1(bf16_t h) { return __builtin_bit_cast(float, (unsigned)h << 16); }
__device__ __forceinline__ void unpack8(const u32x4 w, float (&v)[8]) { v[0] = bflo(w.x); v[1] = bfhi(w.x); v[2] = bflo(w.y); v[3] = bfhi(w.y); v[4] = bflo(w.z); v[5] = bfhi(w.z); v[6] = bflo(w.w); v[7] = bfhi(w.w); }
__device__ __forceinline__ u32x4 pack8(const float (&v)[8]) { u32x4 w; w.x = pk2(v[0], v[1]); w.y = pk2(v[2], v[3]); w.z = pk2(v[4], v[5]); w.w = pk2(v[6], v[7]); return w; }
__device__ __forceinline__ float frcp(float x) { return __builtin_amdgcn_rcpf(x); }
__device__ __forceinline__ float sigmoidf_(float x) { return frcp(1.0f + __expf(-x)); }
__device__ __forceinline__ float gelu_t(float x) { const float y = 1.5957691216f * (x + 0.044715f * x * x * x); return x * frcp(1.0f + __expf(-y)); }
__device__ __forceinline__ int opaque_tid() { int t = threadIdx.x; asm volatile("" : "+v"(t)); return t; }
__device__ __forceinline__ float wave_sum(float v) {
#pragma unroll
    for (int o = 1; o < 64; o <<= 1) v += __shfl_xor(v, o);
    return v;
}


__device__ __forceinline__ void transpose_item(const float* __restrict__ W, int K, int N, bf16_t* __restrict__ WT, LAS float* scr, int item, int lane, const float* __restrict__ gk = nullptr) {
    const int nblk = N >> 6, kb = item / nblk, nb = item - kb * nblk, k0 = kb << 6, n0 = nb << 6;
    const int rr = lane >> 4, c4 = (lane & 15) << 2;
#pragma unroll 4
    for (int i = 0; i < 16; ++i) { const int kk = 4 * i + rr; f32x4 v = *(const f32x4*)(W + (size_t)(k0 + kk) * N + n0 + c4); if (gk) v = v * gk[k0 + kk];
        scr[kk * 65 + c4 + 0] = v[0]; scr[kk * 65 + c4 + 1] = v[1]; scr[kk * 65 + c4 + 2] = v[2]; scr[kk * 65 + c4 + 3] = v[3]; }
    asm volatile("s_waitcnt lgkmcnt(0)" ::: "memory");
    const int c = lane & 7;
#pragma unroll
    for (int j = 0; j < 8; ++j) { const int n = (lane >> 3) + 8 * j; const LAS float* s = scr + (8 * c) * 65 + n;
        u32x4 o; o.x = pk2(s[0 * 65], s[1 * 65]); o.y = pk2(s[2 * 65], s[3 * 65]); o.z = pk2(s[4 * 65], s[5 * 65]); o.w = pk2(s[6 * 65], s[7 * 65]);
        *(u32x4*)(WT + (size_t)(n0 + n) * K + k0 + 8 * c) = o; }
    asm volatile("s_waitcnt lgkmcnt(0)" ::: "memory");
}

__device__ __forceinline__ void phase_prep(const Args& a, LAS unsigned char* lds, int bid, int NGW) {
    const int tid = opaque_tid(), lane = tid & 63, wave = __builtin_amdgcn_readfirstlane(tid >> 6), gw = bid * 8 + wave;
    LAS float* scr = (LAS float*)(lds + wave * 16640);
    constexpr int I_IN = (DM / 64) * (DIN / 64), I_OUT = (DM / 64) * (DM / 64), I_F1 = (DM / 64) * (DFF / 64), I_F2 = (DFF / 64) * (DM / 64), I_G = 2 * 8 * 4;
    constexpr int PER_LAYER = I_IN + I_OUT + I_F1 + I_F2 + I_G;
    for (int it = gw; it < DEPTH * PER_LAYER; it += NGW) {
        const int l = it / PER_LAYER; int r = it - l * PER_LAYER;
        if (r < I_IN) { transpose_item(a.in[I_WIN] + (size_t)l * DM * DIN, DM, DIN, (bf16_t*)(a.ws + WS_WIN) + (size_t)l * DM * DIN, scr, r, lane, a.in[I_NMIX] + (size_t)l * DM); continue; } r -= I_IN;
        if (r < I_OUT) { transpose_item(a.in[I_WOUT] + (size_t)l * DM * DM, DM, DM, (bf16_t*)(a.ws + WS_WOUT) + (size_t)l * DM * DM, scr, r, lane); continue; } r -= I_OUT;
        if (r < I_F1) { transpose_item(a.in[I_WFF1] + (size_t)l * DM * DFF, DM, DFF, (bf16_t*)(a.ws + WS_WFF1) + (size_t)l * DM * DFF, scr, r, lane, a.in[I_NFFN] + (size_t)l * DM); continue; } r -= I_F1;
        if (r < I_F2) { transpose_item(a.in[I_WFF2] + (size_t)l * DM * DFF, DFF, DM, (bf16_t*)(a.ws + WS_WFF2) + (size_t)l * DM * DFF, scr, r, lane); continue; } r -= I_F2;
        { const int g = r >> 5, h = (r >> 2) & 7, sub = r & 3;
          const float* src = (g ? a.in[I_GIW] : a.in[I_GRW]) + ((size_t)l * 8 + h) * 16384;
          bf16_t* dst = (bf16_t*)(a.ws + WS_GATE) + (((size_t)l * 2 + g) * 8 + h) * 16384;
          transpose_item(src, 128, 128, dst, scr, sub, lane); }
    }
    const float* sw = a.in[I_SW]; bf16_t* so = (bf16_t*)(a.ws + WS_SGUW);
    for (int i = gw * 64 + lane; i < DEPTH * 4 * 128 * 128; i += NGW * 64) { const int s = i & 127, t = (i >> 7) & 127; so[i] = (bf16_t)(s <= t ? f2bf(sw[i]) : 0u); }
}

__device__ __forceinline__ void phase_rms(const float* xp, const float* xs, const float* __restrict__ g, bf16_t* obf, float* of32, int bid, int NGW, const float* part = nullptr, float* xs_wb = nullptr, float* rss_out = nullptr) {
#ifdef DIS_R
    return;
#endif
    const int tid = opaque_tid(), lane = tid & 63, gw = bid * 8 + __builtin_amdgcn_readfirstlane(tid >> 6);
    f32x4 gv[8];
#pragma unroll
    for (int j = 0; j < 8; ++j) gv[j] = ((const f32x4*)g)[lane + 64 * j];
    for (int r = gw; r < MV; r += NGW) {
        const f32x4* xr = (const f32x4*)(r < MPROMPT ? xp + (size_t)r * DM : xs + (size_t)(r - MPROMPT) * DM);
        f32x4 v[8]; float ss = 0.f;
#pragma unroll
        for (int j = 0; j < 8; ++j) v[j] = xr[lane + 64 * j];
        if (part && r >= MPROMPT) {
#pragma unroll 1
            for (int ks = 0; ks < 8; ks += 2) { const f32x4* pr = (const f32x4*)(part + ((size_t)ks * NS + (r - MPROMPT)) * DM); const f32x4* pr2 = pr + (size_t)NS * DM / 4;
                f32x4 t0[8], t1[8];
#pragma unroll
                for (int j = 0; j < 8; ++j) { t0[j] = pr[lane + 64 * j]; t1[j] = pr2[lane + 64 * j]; }
                __builtin_amdgcn_sched_barrier(0);
#pragma unroll
                for (int j = 0; j < 8; ++j) v[j] += t0[j] + t1[j]; }
            f32x4* wb = (f32x4*)(xs_wb + (size_t)(r - MPROMPT) * DM);
#pragma unroll
            for (int j = 0; j < 8; ++j) wb[lane + 64 * j] = v[j];
        }
#pragma unroll
        for (int j = 0; j < 8; ++j) ss += (v[j][0] * v[j][0] + v[j][1] * v[j][1]) + (v[j][2] * v[j][2] + v[j][3] * v[j][3]);
        ss = wave_sum(ss);
        if (rss_out) {
            u32x2* o = (u32x2*)(obf + (size_t)r * DM);
#pragma unroll
            for (int j = 0; j < 8; ++j) { u32x2 w; w.x = pk2(v[j][0], v[j][1]); w.y = pk2(v[j][2], v[j][3]); o[lane + 64 * j] = w; }
            if (lane == 0) rss_out[r] = ss;
            continue;
        }
        const float rstd = 1.0f / sqrtf(ss * (1.0f / DM) + EPS);
        if (obf) { u32x2* o = (u32x2*)(obf + (size_t)r * DM);
#pragma unroll
            for (int j = 0; j < 8; ++j) { const f32x4 y = v[j] * rstd * gv[j]; u32x2 w; w.x = pk2(y[0], y[1]); w.y = pk2(y[2], y[3]); o[lane + 64 * j] = w; }
        } else { f32x4* o = (f32x4*)(of32 + (size_t)r * DM);
#pragma unroll
            for (int j = 0; j < 8; ++j) o[lane + 64 * j] = v[j] * rstd * gv[j]; }
    }
}

__device__ __forceinline__ void mixA_item(const Args& a, LAS unsigned char* lds, int l, int item) {
    const int tid = opaque_tid(), lane = tid & 63, wid = __builtin_amdgcn_readfirstlane(tid >> 6);
    const bool samp = item >= 512;
    const int tt = samp ? 64 : (item >> 3), h = samp ? (item - 512) : (item & 7);
    const int ti = tt & 15, r0 = tt * 128, c0 = h * 128, bseq = tt >> 4;
    const bf16_t* Z = (const bf16_t*)(a.ws + WS_Z);
    LAS bf16_t* AT = (LAS bf16_t*)lds;
    LAS float* AA = (LAS float*)lds;
    LAS float* UU = (LAS float*)(lds + 67584);
    LAS float* SP = (LAS float*)(lds + 135168);
    LAS float* SH = SP + 512;
    LAS float* CP = SH + 512;
    LAS float* CH = CP + 512;
    const float* caw = a.in[I_CAW] + (size_t)l * 4 * WA; const float* cab = a.in[I_CAB] + (size_t)l * WA;
    const int fr = lane & 15, fq = lane >> 4;
    bf16x8 gbr[4], gbi[4]; float brb_c, bib_c, lam_c;
    { const bf16_t* GR = (const bf16_t*)(a.ws + WS_GATE) + (((size_t)l * 2 + 0) * 8 + h) * 16384 + (size_t)(16 * wid + fr) * 128 + fq * 8;
      const bf16_t* GI = (const bf16_t*)(a.ws + WS_GATE) + (((size_t)l * 2 + 1) * 8 + h) * 16384 + (size_t)(16 * wid + fr) * 128 + fq * 8;
#pragma unroll
      for (int ks = 0; ks < 4; ++ks) { gbr[ks] = *(const bf16x8*)(GR + ks * 32); gbi[ks] = *(const bf16x8*)(GI + ks * 32); }
      const int c = c0 + 16 * wid + fr; brb_c = a.in[I_GRB][(size_t)l * WA + c]; bib_c = a.in[I_GIB][(size_t)l * WA + c]; lam_c = a.in[I_LAM][(size_t)l * WA + c]; }
    {
        const int kc = (tid & 15) * 8, c = c0 + kc, tb = tid >> 4;
        float wv[4][8], bias[8];
        { const f32x4 b0 = *(const f32x4*)(cab + c), b1 = *(const f32x4*)(cab + c + 4);
#pragma unroll
          for (int e = 0; e < 4; ++e) { bias[e] = b0[e]; bias[4 + e] = b1[e]; }
#pragma unroll
          for (int j = 0; j < 4; ++j) { const f32x4 w0 = *(const f32x4*)(caw + (size_t)j * WA + c), w1 = *(const f32x4*)(caw + (size_t)j * WA + c + 4);
#pragma unroll
              for (int e = 0; e < 4; ++e) { wv[j][e] = w0[e]; wv[j][4 + e] = w1[e]; } } }
        if (!samp) {
            u32x4 zr[4][4];
#pragma unroll
            for (int i = 0; i < 4; ++i)
#pragma unroll
                for (int j = 0; j < 4; ++j) { const int tr = tb + 32 * i - 3 + j; const int trc = (ti * 128 + tr >= 0) ? tr : 0;
                    zr[i][j] = *(const u32x4*)(Z + (size_t)(r0 + trc) * DIN + ZXA + c); }
            __builtin_amdgcn_sched_barrier(0);
#pragma unroll
            for (int i = 0; i < 4; ++i) { const int t = tb + 32 * i; float acc[8];
#pragma unroll
                for (int e = 0; e < 8; ++e) acc[e] = bias[e];
#pragma unroll
                for (int j = 0; j < 4; ++j) { float xv[8]; unpack8(zr[i][j], xv); const float msk = (ti * 128 + t - 3 + j >= 0) ? 1.f : 0.f;
#pragma unroll
                    for (int e = 0; e < 8; ++e) acc[e] += wv[j][e] * (xv[e] * msk);
                    if (j == 3 && ti == 15 && t >= 125) { float* o = a.out + O_CAP + (((size_t)l * NB + bseq) * 3 + (t - 125)) * WA + c;
                        *(f32x4*)o = (f32x4){xv[0], xv[1], xv[2], xv[3]}; *(f32x4*)(o + 4) = (f32x4){xv[4], xv[5], xv[6], xv[7]}; } }
                *(LAS u32x4*)(AT + t * 136 + kc) = pack8(acc); }
        } else {
            u32x4 zr[4]; f32x4 sv[4][3][2];
#pragma unroll
            for (int i = 0; i < 4; ++i) { const int t = tb + 32 * i; zr[i] = *(const u32x4*)(Z + (size_t)(MPROMPT + t) * DIN + ZXA + c);
#pragma unroll
                for (int j = 0; j < 3; ++j) { const float* sp = a.in[I_SCA] + (((size_t)l * NS + t) * 3 + j) * WA + c; sv[i][j][0] = *(const f32x4*)sp; sv[i][j][1] = *(const f32x4*)(sp + 4); } }
            __builtin_amdgcn_sched_barrier(0);
#pragma unroll
            for (int i = 0; i < 4; ++i) { const int t = tb + 32 * i; float acc[8];
#pragma unroll
                for (int e = 0; e < 8; ++e) acc[e] = bias[e];
#pragma unroll
                for (int j = 0; j < 4; ++j) { float xv[8];
                    if (j < 3) {
#pragma unroll
                        for (int e = 0; e < 4; ++e) { xv[e] = sv[i][j][0][e]; xv[4 + e] = sv[i][j][1][e]; } }
                    else unpack8(zr[i], xv);
#pragma unroll
                    for (int e = 0; e < 8; ++e) acc[e] += wv[j][e] * xv[e];
                    if (j >= 1) { float* o = a.out + O_CAS + (((size_t)l * NS + t) * 3 + (j - 1)) * WA + c;
                        *(f32x4*)o = (f32x4){xv[0], xv[1], xv[2], xv[3]}; *(f32x4*)(o + 4) = (f32x4){xv[4], xv[5], xv[6], xv[7]}; } }
                *(LAS u32x4*)(AT + t * 136 + kc) = pack8(acc); }
        }
    }
    __syncthreads();
    f32x4 accr[8], acci[8];
#pragma unroll
    for (int m = 0; m < 8; ++m) { accr[m] = (f32x4){0.f, 0.f, 0.f, 0.f}; acci[m] = (f32x4){0.f, 0.f, 0.f, 0.f}; }
#pragma unroll
    for (int ks = 0; ks < 4; ++ks) {
#pragma unroll
        for (int m = 0; m < 8; ++m) {
            const bf16x8 af = *(const LAS bf16x8*)(AT + (16 * m + fr) * 136 + ks * 32 + fq * 8);
            accr[m] = __builtin_amdgcn_mfma_f32_16x16x32_bf16(af, gbr[ks], accr[m], 0, 0, 0);
            acci[m] = __builtin_amdgcn_mfma_f32_16x16x32_bf16(af, gbi[ks], acci[m], 0, 0, 0);
        }
    }
    {
        const float LP = -8.0f * log1pf(expf(-lam_c));
#pragma unroll
        for (int m = 0; m < 8; ++m) {
#pragma unroll
            for (int j = 0; j < 4; ++j) {
                const int t = 16 * m + 4 * fq + j;
                const float xc = bf1(AT[t * 136 + 16 * wid + fr]);
                const float rg = sigmoidf_(accr[m][j] + brb_c), ig = sigmoidf_(acci[m][j] + bib_c);
                const float la = rg * LP, x2 = 2.0f * la;
                const float av = __expf(la);
                const float ser = -x2 * (1.0f + x2 * (0.5f + x2 * (0.16666667f + x2 * (0.041666668f + x2 * (0.0083333338f + x2 * 0.0013888889f)))));
                const float om = x2 > -0.25f ? ser : 1.0f - av * av;
                accr[m][j] = av;
                acci[m][j] = __builtin_amdgcn_sqrtf(om) * (ig * xc);
            }
        }
    }
    __syncthreads();
#pragma unroll
    for (int m = 0; m < 8; ++m)
#pragma unroll
        for (int j = 0; j < 4; ++j) { const int t = 16 * m + 4 * fq + j; AA[t * 132 + 16 * wid + fr] = accr[m][j]; UU[t * 132 + 16 * wid + fr] = acci[m][j]; }
    __syncthreads();
    if (!samp) {
        { const int k = tid & 127, seg = tid >> 7; float P = 1.f, hl = 0.f;
#pragma unroll 8
          for (int q = 0; q < 32; ++q) { const int t = 32 * seg + q; const float av = AA[t * 132 + k], uv = UU[t * 132 + k]; P *= av; hl = av * hl + uv; AA[t * 132 + k] = P; UU[t * 132 + k] = hl; }
          SP[seg * 128 + k] = P; SH[seg * 128 + k] = hl;
          __syncthreads();
          float Pc = 1.f, Hc = 0.f;
          for (int s = 0; s < seg; ++s) { const float ps = SP[s * 128 + k], hs = SH[s * 128 + k]; Hc = ps * Hc + hs; Pc *= ps; }
          CP[seg * 128 + k] = Pc; CH[seg * 128 + k] = Hc;
          if (seg == 3) { float* ca = (float*)(a.ws + WS_CARRY); ca[(size_t)tt * WA + c0 + k] = Pc * P; ca[(size_t)(64 + tt) * WA + c0 + k] = P * Hc + hl; }
          __syncthreads(); }
        bf16_t* HL = (bf16_t*)(a.ws + WS_HLOC); bf16_t* PL = (bf16_t*)(a.ws + WS_PCUM);
#pragma unroll
        for (int i = 0; i < 4; ++i) {
            const int chunk = tid + 512 * i, t = chunk >> 4, kc = (chunk & 15) * 8, sg = t >> 5;
            float hv[8], pv[8];
            const f32x4 p0 = *(const LAS f32x4*)(AA + t * 132 + kc), p1 = *(const LAS f32x4*)(AA + t * 132 + kc + 4), h0 = *(const LAS f32x4*)(UU + t * 132 + kc), h1 = *(const LAS f32x4*)(UU + t * 132 + kc + 4);
            const f32x4 cp0 = *(const LAS f32x4*)(CP + sg * 128 + kc), cp1 = *(const LAS f32x4*)(CP + sg * 128 + kc + 4), ch0 = *(const LAS f32x4*)(CH + sg * 128 + kc), ch1 = *(const LAS f32x4*)(CH + sg * 128 + kc + 4);
#pragma unroll
            for (int e = 0; e < 4; ++e) { hv[e] = h0[e] + p0[e] * ch0[e]; pv[e] = p0[e] * cp0[e]; hv[4 + e] = h1[e] + p1[e] * ch1[e]; pv[4 + e] = p1[e] * cp1[e]; }
            *(u32x4*)(HL + (size_t)(r0 + t) * WA + c0 + kc) = pack8(hv);
            *(u32x4*)(PL + (size_t)(r0 + t) * WA + c0 + kc) = pack8(pv);
        }
    } else {
        bf16_t* MIX = (bf16_t*)(a.ws + WS_MIX);
#pragma unroll
        for (int i = 0; i < 4; ++i) {
            const int chunk = tid + 512 * i, b = chunk >> 4, kc = (chunk & 15) * 8, c = c0 + kc;
            const float* h0 = a.in[I_SH] + ((size_t)l * NS + b) * WA + c; const f32x4 h00 = *(const f32x4*)h0, h01 = *(const f32x4*)(h0 + 4);
            float ga[8]; unpack8(*(const u32x4*)(Z + (size_t)(MPROMPT + b) * DIN + ZGA + c), ga);
            float hv[8], yv[8];
#pragma unroll
            for (int e = 0; e < 8; ++e) { const float hp = e < 4 ? h00[e & 3] : h01[e & 3]; hv[e] = AA[b * 132 + kc + e] * hp + UU[b * 132 + kc + e]; yv[e] = hv[e] * gelu_t(ga[e]); }
            float* ho = a.out + O_HS + ((size_t)l * NS + b) * WA + c;
            *(f32x4*)ho = (f32x4){hv[0], hv[1], hv[2], hv[3]}; *(f32x4*)(ho + 4) = (f32x4){hv[4], hv[5], hv[6], hv[7]};
            *(u32x4*)(MIX + (size_t)(MPROMPT + b) * DM + MYA + c) = pack8(yv);
        }
    }
    __syncthreads();
}

__device__ __forceinline__ void mixA2_item(const Args& a, LAS unsigned char* lds, int l, int item) {
    const int tid = opaque_tid();
    const int tt = item >> 3, h = item & 7, ti = tt & 15, r0 = tt * 128, c0 = h * 128, bseq = tt >> 4;
    LAS float* HIN = (LAS float*)lds;
    const float* ca = (const float*)(a.ws + WS_CARRY);
    if (tid < 128) { float Hc = 0.f; float ca_[15], ch_[15];
#pragma unroll
        for (int j = 0; j < 15; ++j) { const int t2 = tt - ti + (j < ti ? j : 0); ca_[j] = ca[(size_t)t2 * WA + c0 + tid]; ch_[j] = ca[(size_t)(64 + t2) * WA + c0 + tid]; }
        __builtin_amdgcn_sched_barrier(0);
#pragma unroll
        for (int j = 0; j < 15; ++j) { const float aj = j < ti ? ca_[j] : 1.f, hj = j < ti ? ch_[j] : 0.f; Hc = aj * Hc + hj; }
        HIN[tid] = Hc;
        if (ti == 15) a.out[O_HP + ((size_t)l * NB + bseq) * WA + c0 + tid] = ca[(size_t)tt * WA + c0 + tid] * Hc + ca[(size_t)(64 + tt) * WA + c0 + tid]; }
    __syncthreads();
    const bf16_t* Z = (const bf16_t*)(a.ws + WS_Z); const bf16_t* HL = (const bf16_t*)(a.ws + WS_HLOC); const bf16_t* PL = (const bf16_t*)(a.ws + WS_PCUM); bf16_t* MIX = (bf16_t*)(a.ws + WS_MIX);
    {   const int kc = (tid & 15) * 8, c = c0 + kc, tb = tid >> 4;
        u32x4 hr[4], pr[4], gr[4];
#pragma unroll
        for (int i = 0; i < 4; ++i) { const size_t row = (size_t)(r0 + tb + 32 * i); hr[i] = *(const u32x4*)(HL + row * WA + c); pr[i] = *(const u32x4*)(PL + row * WA + c); gr[i] = *(const u32x4*)(Z + row * DIN + ZGA + c); }
        __builtin_amdgcn_sched_barrier(0);
#pragma unroll
        for (int i = 0; i < 4; ++i) { float hv[8], pv[8], ga[8], yv[8]; unpack8(hr[i], hv); unpack8(pr[i], pv); unpack8(gr[i], ga);
#pragma unroll
            for (int e = 0; e < 8; ++e) yv[e] = (hv[e] + pv[e] * HIN[kc + e]) * gelu_t(ga[e]);
            *(u32x4*)(MIX + (size_t)(r0 + tb + 32 * i) * DM + MYA + c) = pack8(yv); }
    }
    __syncthreads();
}

__device__ __forceinline__ void lnB_rows(const Args& a, LAS float* Y, int l, int ntok, int row0, int wid, int lane) {
    const float* g = a.in[I_LNBG] + (size_t)l * WB + 8 * lane; const float* bb = a.in[I_LNBB] + (size_t)l * WB + 8 * lane; bf16_t* MIX = (bf16_t*)(a.ws + WS_MIX);
    float gg[8], bv[8];
    { const f32x4 g0 = *(const f32x4*)g, g1 = *(const f32x4*)(g + 4), b0 = *(const f32x4*)bb, b1 = *(const f32x4*)(bb + 4);
#pragma unroll
      for (int e = 0; e < 4; ++e) { gg[e] = g0[e]; gg[4 + e] = g1[e]; bv[e] = b0[e]; bv[4 + e] = b1[e]; } }
    __builtin_amdgcn_sched_barrier(0);
    if (ntok == 32) {
        float v[4][8], s[4], q[4];
#pragma unroll
        for (int k = 0; k < 4; ++k) { const f32x4 y0 = *(const LAS f32x4*)(Y + (wid + 8 * k) * 512 + 8 * lane), y1 = *(const LAS f32x4*)(Y + (wid + 8 * k) * 512 + 8 * lane + 4); s[k] = 0.f;
#pragma unroll
            for (int e = 0; e < 4; ++e) { v[k][e] = y0[e]; v[k][4 + e] = y1[e]; s[k] += y0[e] + y1[e]; } }
#pragma unroll
        for (int o = 1; o < 64; o <<= 1) {
#pragma unroll
            for (int k = 0; k < 4; ++k) s[k] += __shfl_xor(s[k], o); }
#pragma unroll
        for (int k = 0; k < 4; ++k) { const float mean = s[k] * (1.0f / WB); q[k] = 0.f;
#pragma unroll
            for (int i = 0; i < 8; ++i) { v[k][i] -= mean; q[k] += v[k][i] * v[k][i]; } }
#pragma unroll
        for (int o = 1; o < 64; o <<= 1) {
#pragma unroll
            for (int k = 0; k < 4; ++k) q[k] += __shfl_xor(q[k], o); }
#pragma unroll
        for (int k = 0; k < 4; ++k) { const float rstd = 1.0f / sqrtf(q[k] * (1.0f / WB) + EPS); float ov[8];
#pragma unroll
            for (int i = 0; i < 8; ++i) { const float o = v[k][i] * rstd * gg[i] + bv[i]; ov[i] = o * sigmoidf_(o); }
            *(u32x4*)(MIX + (size_t)(row0 + wid + 8 * k) * DM + MYB + 8 * lane) = pack8(ov); }
        return;
    }
    for (int t = wid; t < ntok; t += 8) {
        float v[8]; float s = 0.f;
        { const f32x4 y0 = *(const LAS f32x4*)(Y + t * 512 + 8 * lane), y1 = *(const LAS f32x4*)(Y + t * 512 + 8 * lane + 4);
#pragma unroll
          for (int e = 0; e < 4; ++e) { v[e] = y0[e]; v[4 + e] = y1[e]; s += y0[e] + y1[e]; } }
        const float mean = wave_sum(s) * (1.0f / WB); float q = 0.f;
#pragma unroll
        for (int i = 0; i < 8; ++i) { v[i] -= mean; q += v[i] * v[i]; }
        const float rstd = 1.0f / sqrtf(wave_sum(q) * (1.0f / WB) + EPS); float ov[8];
#pragma unroll
        for (int i = 0; i < 8; ++i) { const float o = v[i] * rstd * gg[i] + bv[i]; ov[i] = o * sigmoidf_(o); }
        *(u32x4*)(MIX + (size_t)(row0 + t) * DM + MYB + 8 * lane) = pack8(ov);
    }
}
__device__ __forceinline__ void mixB_item(const Args& a, LAS unsigned char* lds, int l, int item) {
    const int tid = opaque_tid(), lane = tid & 63, wid = __builtin_amdgcn_readfirstlane(tid >> 6);
    const bf16_t* Z = (const bf16_t*)(a.ws + WS_Z);
    LAS float* Y = (LAS float*)lds;
    const int c = tid;
    float w[31];
#pragma unroll
    for (int j = 0; j < 31; ++j) w[j] = a.in[I_CBW][((size_t)l * KB + j) * WB + c];
    if (item < 256) {
        const int bseq = item >> 6, tq = item & 63, r0 = item * 32;
        float ub[62];
        { bf16_t xr[62], gr[62];
#pragma unroll
          for (int k = 0; k < 62; ++k) { const int pos = tq * 32 + k - 30; const size_t ro = (size_t)(bseq * SEQ + (pos >= 0 ? pos : 0)) * DIN; xr[k] = Z[ro + ZXB + c]; gr[k] = Z[ro + ZGB + c]; }
          __builtin_amdgcn_sched_barrier(0);
#pragma unroll
          for (int k = 0; k < 62; ++k) { const int pos = tq * 32 + k - 30; const float v = bf1(xr[k]) * sigmoidf_(bf1(gr[k])); ub[k] = pos >= 0 ? v : 0.f; } }
#pragma unroll
        for (int t = 0; t < 32; ++t) { float y = 0.f;
#pragma unroll
            for (int j = 0; j < 31; ++j) y += w[j] * ub[t + j];
            Y[t * 512 + c] = y; }
        if (tq == 63) {
#pragma unroll
            for (int j = 0; j < 30; ++j) a.out[O_CBP + (((size_t)l * NB + bseq) * 30 + j) * WB + c] = ub[32 + j]; }
        __syncthreads();
        lnB_rows(a, Y, l, 32, r0, wid, lane);
    } else {
        const int is = item - 256;
#pragma unroll 1
        for (int q = 0; q < 4; ++q) {
            const int b = is * 4 + q; float y = 0.f;
            const float* st = a.in[I_SCB] + ((size_t)l * NS + b) * 30 * WB + c; float* co = a.out + O_CBS + ((size_t)l * NS + b) * 30 * WB + c;
            float sv[30];
#pragma unroll
            for (int j = 0; j < 30; ++j) sv[j] = st[(size_t)j * WB];
            const size_t ro = (size_t)(MPROMPT + b) * DIN; const bf16_t xbr = Z[ro + ZXB + c], gbr = Z[ro + ZGB + c];
            __builtin_amdgcn_sched_barrier(0);
#pragma unroll
            for (int j = 0; j < 30; ++j) { y += w[j] * sv[j]; if (j >= 1) co[(size_t)(j - 1) * WB] = sv[j]; }
            const float un = bf1(xbr) * sigmoidf_(bf1(gbr));
            y += w[30] * un; co[(size_t)29 * WB] = un;
            Y[q * 512 + c] = y;
        }
        __syncthreads();
        lnB_rows(a, Y, l, 4, MPROMPT + is * 4, wid, lane);
    }
    __syncthreads();
}

__device__ __forceinline__ void mixC_item(const Args& a, LAS unsigned char* lds, int l, int item) {
    const int tid = opaque_tid(), lane = tid & 63, wid = __builtin_amdgcn_readfirstlane(tid >> 6);
    const bf16_t* Z = (const bf16_t*)(a.ws + WS_Z); bf16_t* MIX = (bf16_t*)(a.ws + WS_MIX);
    const float* lg = a.in[I_SLG] + (size_t)l * WC; const float* lb = a.in[I_SLB] + (size_t)l * WC;
    if (item < 256) {
        const int tt = item >> 2, h = item & 3, r0 = tt * 128;
        LAS float* ST = (LAS float*)lds;
        LAS bf16_t* VT = (LAS bf16_t*)(lds + 1024);
        {
            u32x4 zr[16];
#pragma unroll
            for (int tk = 0; tk < 16; ++tk) zr[tk] = *(const u32x4*)(Z + (size_t)(r0 + 16 * wid + tk) * DIN + ZVC + lane * 8);
            __builtin_amdgcn_sched_barrier(0);
            float s1[16], s2[16];
#pragma unroll
            for (int tk = 0; tk < 16; ++tk) { float v[8]; unpack8(zr[tk], v); float p = 0.f, q = 0.f;
#pragma unroll
                for (int e = 0; e < 8; ++e) { const float gv = gelu_t(v[e]); p += gv; q += gv * gv; }
                s1[tk] = p; s2[tk] = q; }
#pragma unroll
            for (int o = 1; o < 64; o <<= 1) {
#pragma unroll
                for (int tk = 0; tk < 16; ++tk) { s1[tk] += __shfl_xor(s1[tk], o); s2[tk] += __shfl_xor(s2[tk], o); } }
#pragma unroll
            for (int tk = 0; tk < 16; ++tk) if (lane == tk) { const float mean = s1[tk] * (1.0f / WC); const float var = fmaxf(s2[tk] * (1.0f / WC) - mean * mean, 0.f);
                ST[2 * (16 * wid + tk)] = mean; ST[2 * (16 * wid + tk) + 1] = 1.0f / sqrtf(var + EPS); }
        }
        __syncthreads();
        {   const int dc = (tid & 15) * 8, cc = h * 128 + dc, sb = tid >> 4;
            u32x4 zr[4];
#pragma unroll
            for (int i = 0; i < 4; ++i) zr[i] = *(const u32x4*)(Z + (size_t)(r0 + sb + 32 * i) * DIN + ZVC + cc);
            __builtin_amdgcn_sched_barrier(0);
            const f32x4 g0 = *(const f32x4*)(lg + cc), g1 = *(const f32x4*)(lg + cc + 4), b0 = *(const f32x4*)(lb + cc), b1 = *(const f32x4*)(lb + cc + 4);
#pragma unroll
            for (int i = 0; i < 4; ++i) { const int s = sb + 32 * i; float v[8]; unpack8(zr[i], v);
                const float mean = ST[2 * s], rstd = ST[2 * s + 1];
#pragma unroll
                for (int e = 0; e < 8; ++e) { const float gg = e < 4 ? g0[e & 3] : g1[e & 3], bv = e < 4 ? b0[e & 3] : b1[e & 3];
                    VT[(dc + e) * 136 + (s ^ ((tid & 15) << 3))] = (bf16_t)f2bf((gelu_t(v[e]) - mean) * rstd * gg + bv); } }
        }
        __syncthreads();
        const int fr = lane & 15, fq = lane >> 4;
        f32x4 acc[8];
#pragma unroll
        for (int n = 0; n < 8; ++n) acc[n] = (f32x4){0.f, 0.f, 0.f, 0.f};
        const bf16_t* SW = (const bf16_t*)(a.ws + WS_SGUW) + ((size_t)l * 4 + h) * 16384;
        const int nks = (16 * wid + 16 + 31) >> 5;
        for (int ks = 0; ks < nks; ++ks) {
            const bf16x8 wf = *(const bf16x8*)(SW + (size_t)(16 * wid + fr) * 128 + ks * 32 + fq * 8);
#pragma unroll
            for (int n = 0; n < 8; ++n) { const bf16x8 vf = *(const LAS bf16x8*)(VT + (n * 16 + fr) * 136 + (((ks * 4 + fq) ^ (2 * n + (fr >> 3))) << 3));
                acc[n] = __builtin_amdgcn_mfma_f32_16x16x32_bf16(vf, wf, acc[n], 0, 0, 0); }
        }
        const int t = 16 * wid + fr; const float bs = a.in[I_SB][((size_t)l * 4 + h) * 128 + t]; const size_t row = (size_t)(r0 + t);
        u32x2 uwv[8];
#pragma unroll
        for (int n = 0; n < 8; ++n) uwv[n] = *(const u32x2*)(Z + row * DIN + ZUC + h * 128 + n * 16 + 4 * fq);
        __builtin_amdgcn_sched_barrier(0);
#pragma unroll
        for (int n = 0; n < 8; ++n) { const int d0 = n * 16 + 4 * fq; const u32x2 uw = uwv[n];
            const float u0 = gelu_t(bflo(uw.x)), u1 = gelu_t(bfhi(uw.x)), u2 = gelu_t(bflo(uw.y)), u3 = gelu_t(bfhi(uw.y));
            u32x2 o; o.x = pk2(u0 * (acc[n][0] + bs), u1 * (acc[n][1] + bs)); o.y = pk2(u2 * (acc[n][2] + bs), u3 * (acc[n][3] + bs));
            *(u32x2*)(MIX + row * DM + MYC + h * 128 + d0) = o; }
    } else {
        const int is = item - 256;
#pragma unroll 1
        for (int q = 0; q < 2; ++q) {
            const int b = is * 16 + wid * 2 + q; const size_t row = (size_t)(MPROMPT + b); const int cc = lane * 8, h = lane >> 4;
            float v[8]; unpack8(*(const u32x4*)(Z + row * DIN + ZVC + cc), v);
            float s = 0.f;
#pragma unroll
            for (int e = 0; e < 8; ++e) { v[e] = gelu_t(v[e]); s += v[e]; }
            const float mean = wave_sum(s) * (1.0f / WC); float qq = 0.f;
#pragma unroll
            for (int e = 0; e < 8; ++e) { v[e] -= mean; qq += v[e] * v[e]; }
            const float rstd = 1.0f / sqrtf(wave_sum(qq) * (1.0f / WC) + EPS);
            const f32x4 g0 = *(const f32x4*)(lg + cc), g1 = *(const f32x4*)(lg + cc + 4), b0 = *(const f32x4*)(lb + cc), b1 = *(const f32x4*)(lb + cc + 4);
            float uu[8]; unpack8(*(const u32x4*)(Z + row * DIN + ZUC + cc), uu);
            const float w00 = a.in[I_SW][((size_t)l * 4 + h) * 16384], bs = a.in[I_SB][((size_t)l * 4 + h) * 128];
            float yv[8];
#pragma unroll
            for (int e = 0; e < 8; ++e) { const float gg = e < 4 ? g0[e & 3] : g1[e & 3], bv = e < 4 ? b0[e & 3] : b1[e & 3]; v[e] = v[e] * rstd * gg + bv; yv[e] = gelu_t(uu[e]) * (w00 * v[e] + bs); }
            float* vo = a.out + O_VS + ((size_t)l * NS + b) * WC + cc;
            *(f32x4*)vo = (f32x4){v[0], v[1], v[2], v[3]}; *(f32x4*)(vo + 4) = (f32x4){v[4], v[5], v[6], v[7]};
            *(u32x4*)(MIX + row * DM + MYC + cc) = pack8(yv);
        }
    }
    __syncthreads();
}

constexpr int SK_AB = 128 * 72 * 2, SK_BB = 64 * 72 * 2, SK_STAGE = SK_AB + SK_BB;
template <int ACT  , int NT  >
__device__ __forceinline__ void skinny_gemm(LAS unsigned char* lds, const bf16_t* __restrict__ As, const bf16_t* __restrict__ Bt, int K, int N, int KSPLIT, bf16_t* obf, const float* base, float* of32, float* rss, int bid, int G) {
    const int tid = opaque_tid(), lane = tid & 63, wid = __builtin_amdgcn_readfirstlane(tid >> 6), fr = lane & 15, fq = lane >> 4;
    const int ncol = N / (16 * NT), nitems = ncol * KSPLIT, klen = K / KSPLIT, S = klen >> 6;
    const int lrow = tid >> 3, lkc = (tid & 7) * 8;
    for (int it = bid; it < nitems; it += G) {
        const int ct = it % ncol, ks = it / ncol, n0 = ct * (16 * NT), k0 = ks * klen; const bool bl = lrow < 16 * NT;
        const bf16_t* ag0 = As + (size_t)lrow * K + k0 + lkc;
        const bf16_t* ag1 = ag0 + (size_t)64 * K;
        const bf16_t* bg = Bt + (size_t)(n0 + (bl ? lrow : 0)) * K + k0 + lkc;
        u32x4 ra0[4], ra1[4], rb[4];
#pragma unroll
        for (int j = 0; j < 4; ++j) { ra0[j] = *(const u32x4*)(ag0 + j * 64); ra1[j] = *(const u32x4*)(ag1 + j * 64); rb[j] = *(const u32x4*)(bg + j * 64); }
        f32x4 acc[NT];
#pragma unroll
        for (int n = 0; n < NT; ++n) acc[n] = (f32x4){0.f, 0.f, 0.f, 0.f};
        for (int s0 = 0; s0 < S; s0 += 4) {
#pragma unroll
            for (int j = 0; j < 4; ++j) {
                LAS unsigned char* buf = lds + (j & 1) * SK_STAGE;
                LAS bf16_t* At = (LAS bf16_t*)buf; LAS bf16_t* Bs = (LAS bf16_t*)(buf + SK_AB);
                *(LAS u32x4*)(At + lrow * 72 + lkc) = ra0[j]; *(LAS u32x4*)(At + (64 + lrow) * 72 + lkc) = ra1[j]; if (bl) *(LAS u32x4*)(Bs + lrow * 72 + lkc) = rb[j];
                if (s0 + j + 4 < S) { const int ko = (s0 + j + 4) * 64; ra0[j] = *(const u32x4*)(ag0 + ko); ra1[j] = *(const u32x4*)(ag1 + ko); rb[j] = *(const u32x4*)(bg + ko); }
                __syncthreads();
#pragma unroll
                for (int kk = 0; kk < 2; ++kk) {
                    const bf16x8 af = *(const LAS bf16x8*)(At + (16 * wid + fr) * 72 + kk * 32 + fq * 8);
#pragma unroll
                    for (int n = 0; n < NT; ++n) { const bf16x8 bf = *(const LAS bf16x8*)(Bs + (n * 16 + fr) * 72 + kk * 32 + fq * 8);
                        acc[n] = __builtin_amdgcn_mfma_f32_16x16x32_bf16(bf, af, acc[n], 0, 0, 0); }
                }
            }
        }
        __syncthreads();
        const int r = 16 * wid + fr;
        f32x4 bsv[NT]; float rstd = 1.f, ss = 0.f;
        if (ACT == 3) {
#pragma unroll
            for (int n = 0; n < NT; ++n) bsv[n] = *(const f32x4*)(base + (size_t)r * N + n0 + n * 16 + 4 * fq);
            __builtin_amdgcn_sched_barrier(0); }
        if (ACT == 0 || ACT == 2) rstd = __builtin_amdgcn_rsqf(rss[r] * (1.0f / DM) + EPS);
#pragma unroll
        for (int n = 0; n < NT; ++n) {
            const int c = n0 + n * 16 + 4 * fq; f32x4 v = acc[n];
            if (ACT == 3) { v = v + bsv[n]; *(f32x4*)(of32 + (size_t)r * N + c) = v;
                u32x2 w; w.x = pk2(v[0], v[1]); w.y = pk2(v[2], v[3]); *(u32x2*)(obf + (size_t)r * N + c) = w; ss += (v[0] * v[0] + v[1] * v[1]) + (v[2] * v[2] + v[3] * v[3]); }
            else if (ACT == 4) { *(f32x4*)(of32 + ((size_t)ks * 128 + r) * N + c) = v; }
            else {
                v = v * rstd;
                if (ACT == 2) {
#pragma unroll
                    for (int e = 0; e < 4; ++e) { const float t = fmaxf(v[e], 0.f); v[e] = t * t; } }
                u32x2 w; w.x = pk2(v[0], v[1]); w.y = pk2(v[2], v[3]); *(u32x2*)(obf + (size_t)r * N + c) = w; }
        }
        if (ACT == 3) { ss += __shfl_xor(ss, 16); ss += __shfl_xor(ss, 32); if (fq == 0) atomicAdd(rss + r, ss); }
    }
}

__device__ __forceinline__ void sample_fold(const Args& a, int bid, float* rss, unsigned* flag) {
    const int tid = opaque_tid(), lane = tid & 63;
    if (bid < NS && tid < 64) {
        float* xr = (float*)(a.ws + WS_X) + (size_t)(MPROMPT + bid) * DM; bf16_t* hb = (bf16_t*)(a.ws + WS_HN) + (size_t)(MPROMPT + bid) * DM; const float* part = (const float*)(a.ws + WS_PART);
        f32x4 v[8]; float ss = 0.f;
#pragma unroll
        for (int j = 0; j < 8; ++j) v[j] = ((const f32x4*)xr)[lane + 64 * j];
#pragma unroll 1
        for (int ks = 0; ks < 8; ks += 2) { const f32x4* pr = (const f32x4*)(part + ((size_t)ks * NS + bid) * DM); const f32x4* pr2 = pr + (size_t)NS * DM / 4;
            f32x4 t0[8], t1[8];
#pragma unroll
            for (int j = 0; j < 8; ++j) { t0[j] = pr[lane + 64 * j]; t1[j] = pr2[lane + 64 * j]; }
            __builtin_amdgcn_sched_barrier(0);
#pragma unroll
            for (int j = 0; j < 8; ++j) v[j] += t0[j] + t1[j]; }
#pragma unroll
        for (int j = 0; j < 8; ++j) { ((f32x4*)xr)[lane + 64 * j] = v[j]; u32x2 w; w.x = pk2(v[j][0], v[j][1]); w.y = pk2(v[j][2], v[j][3]); ((u32x2*)hb)[lane + 64 * j] = w;
            ss += (v[j][0] * v[j][0] + v[j][1] * v[j][1]) + (v[j][2] * v[j][2] + v[j][3] * v[j][3]); }
        ss = wave_sum(ss);
        if (lane == 0) rss[bid] = ss;
        __threadfence();
        if (lane == 0) __hip_atomic_fetch_add(flag, 1u, __ATOMIC_RELAXED, __HIP_MEMORY_SCOPE_AGENT);
    }
}

#define XB_TMO      128
#define XB_XCNT(j)  (256  + 64 * (j))
#define XB_XSUB(j)  (1280 + 64 * (j))
#define XB_XGEN(j)  (2304 + 64 * (j))
#define XB_TOP      3328
#define XB_TOPGEN   3392
#define XCD_BAR_WORDS 3456
#define XB_SPIN_CAP (1u << 18)

__device__ __forceinline__ unsigned xb_ld(unsigned* p)              { return __hip_atomic_load(p, __ATOMIC_RELAXED, __HIP_MEMORY_SCOPE_AGENT); }
__device__ __forceinline__ unsigned xb_add(unsigned* p, unsigned v) { return __hip_atomic_fetch_add(p, v, __ATOMIC_RELAXED, __HIP_MEMORY_SCOPE_AGENT); }
__device__ __forceinline__ unsigned xb_xcc_id() { return (unsigned)__builtin_amdgcn_s_getreg((3 << 11) | 20) & 0xFu; }
#define XB_SPIN(cond, bar) do { unsigned _sp = 0; while (cond) { __builtin_amdgcn_s_sleep(1); \
    if ((++_sp & 255u) == 0u) { if (xb_ld(&(bar)[XB_TMO])) break; if (_sp > XB_SPIN_CAP) { atomicAdd(&(bar)[XB_TMO], 1u); break; } } } } while (0)

struct XcdBarrier {
    unsigned* bar; unsigned x;
    volatile LAS unsigned* st;
};

__device__ __forceinline__ XcdBarrier xcd_barrier_post(unsigned* bar, volatile LAS unsigned* st) {
    XcdBarrier b; b.bar = bar; b.x = xb_xcc_id(); b.st = st;
    if (threadIdx.x == 0) (void)xb_add(&bar[XB_XCNT(b.x)], 1u);
    return b;
}
__device__ __forceinline__ void xcd_barrier_complete(unsigned* bar, unsigned x, unsigned& nloc, unsigned& nx) {
    const unsigned G = gridDim.x * gridDim.y * gridDim.z;
    unsigned sum, cnt, mine, sp = 0u;
    for (;;) {
        sum = 0u; cnt = 0u; mine = 0u;
#pragma unroll
        for (unsigned j = 0; j < 16; ++j) { const unsigned c = xb_ld(&bar[XB_XCNT(j)]); sum += c; cnt += (c > 0u) ? 1u : 0u; mine = (j == x) ? c : mine; }
        if (sum == G) break;
        __builtin_amdgcn_s_sleep(1);
        if ((++sp & 255u) == 0u) { if (xb_ld(&bar[XB_TMO])) break; if (sp > XB_SPIN_CAP) { atomicAdd(&bar[XB_TMO], 1u); break; } }
    }
    nloc = mine > 0u ? mine : 1u; nx = cnt > 0u ? cnt : 1u;
}

__device__ __forceinline__ void xcd_barrier(const XcdBarrier& b) {
    asm volatile("s_waitcnt vmcnt(0)" ::: "memory");
    __syncthreads();
    if (threadIdx.x == 0) {
        unsigned* bar = b.bar;
        __builtin_amdgcn_s_waitcnt(0);
        unsigned nloc = b.st[0], nx = b.st[1];
        if (nloc == 0u) { xcd_barrier_complete(bar, b.x, nloc, nx); b.st[0] = nloc; b.st[1] = nx; }
        const unsigned old = xb_add(&bar[XB_XSUB(b.x)], 1u);
        const unsigned gen = old / nloc;
        if (old + 1u == (gen + 1u) * nloc) {
            __builtin_amdgcn_fence(__ATOMIC_RELEASE, "agent");
            asm volatile("s_waitcnt vmcnt(0)" ::: "memory");
            const unsigned og = xb_add(&bar[XB_TOP], 1u);
            const unsigned tg = og / nx;
            if (og + 1u == (tg + 1u) * nx) xb_add(&bar[XB_TOPGEN], 1u);
            else XB_SPIN(xb_ld(&bar[XB_TOPGEN]) == tg, bar);
            __builtin_amdgcn_fence(__ATOMIC_ACQUIRE, "agent");
            xb_add(&bar[XB_XGEN(b.x)], 1u);
            asm volatile("s_waitcnt vmcnt(0)" ::: "memory");
        } else {
            XB_SPIN(xb_ld(&bar[XB_XGEN(b.x)]) == gen, bar);
            __builtin_amdgcn_fence(__ATOMIC_ACQUIRE, "agent");
            asm volatile("s_waitcnt vmcnt(0)" ::: "memory");
        }
    }
    __syncthreads();
}

constexpr int N_PHASES = 2 + 6 * DEPTH;
#ifndef REP_MIX
#define REP_MIX 1
#endif
#ifndef FOLD_FLAG
#define FOLD_FLAG 1
#endif
#ifndef WGM_G1
#define WGM_G1 4
#endif
#ifndef WGM_G2
#define WGM_G2 4
#endif
#ifndef WGM_G3
#define WGM_G3 4
#endif
#ifndef WGM_G4
#define WGM_G4 4
#endif
#ifndef REP_A
#define REP_A 1
#endif
#ifndef REP_B
#define REP_B 1
#endif
#ifndef REP_C
#define REP_C 1
#endif
__global__ void __launch_bounds__(512, 2) mega_fwd(Args a) {
    extern __shared__ __attribute__((aligned(16))) unsigned char lds_raw[];
    LAS unsigned char* lds = (LAS unsigned char*)lds_raw;
    cg::grid_group grid = cg::this_grid();
    const int G = gridDim.x, bid = blockIdx.x, NGW = G * 8;
    const int lo = a.ph_lo, hi = a.ph_hi;
    if (lo < 0) grid.sync();
    volatile LAS unsigned* bst = (volatile LAS unsigned*)(lds + LDS_BYTES - 64);
    if (threadIdx.x < 2) bst[threadIdx.x] = 0u;
    __syncthreads();
    XcdBarrier bar = xcd_barrier_post((unsigned*)a.ws, bst);
#define IN(k) (lo <= (k) && (k) < hi)
#define SEAM(k) do { if (IN(k) && IN((k) + 1)) xcd_barrier(bar); } while (0)
    bf16_t* HN = (bf16_t*)(a.ws + WS_HN); bf16_t* Zb = (bf16_t*)(a.ws + WS_Z); bf16_t* MIXb = (bf16_t*)(a.ws + WS_MIX); bf16_t* FFb = (bf16_t*)(a.ws + WS_FF);
    float* X = (float*)(a.ws + WS_X); float* RS = (float*)(a.ws + WS_RS);
    float* Xs = X + (size_t)MPROMPT * DM; bf16_t* HNs = HN + (size_t)MPROMPT * DM;

    if (IN(0)) { phase_prep(a, lds, bid, NGW); phase_rms(a.in[I_XP], a.in[I_XS], a.in[I_NMIX], HN, nullptr, bid, NGW, nullptr, nullptr, RS); }
    SEAM(0);
#ifdef REP_SYNC
    for (int rep = 0; rep < REP_SYNC; ++rep) xcd_barrier(bar);
#endif
#pragma unroll 1
    for (int l = 0; l < DEPTH; ++l) {
        const int p = 1 + 6 * l;
        float* rsA = RS + (size_t)(2 * l) * MV; float* rsF = RS + (size_t)(2 * l + 1) * MV; float* rsN = RS + (size_t)(2 * l + 2) * MV;
        if (IN(p)) {
            const bf16_t* Wt = (const bf16_t*)(a.ws + WS_WIN) + (size_t)l * DM * DIN;
            pg8::Gemm g{HN, Wt, MPROMPT, DIN, DM}; pg8::StaticOrder S; S.init(MPROMPT, DIN, G, bid, WGM_G1);
            pg8::EpiBf16<0> E{Zb, DIN, rsA, 1.0f / DM, EPS};
            unsigned* sflag = (unsigned*)(a.ws + WS_QCTR) + 64 * (8 + l);
            if (FOLD_FLAG && l > 0) sample_fold(a, bid, rsA + MPROMPT, sflag);
            pg8::gemm_phase<pg8::EpiBf16<0>, pg8::StaticOrder, true, true>(lds, g, S, E);
            if (FOLD_FLAG && l > 0) {
                if (threadIdx.x == 0) { unsigned sp = 0; while (__hip_atomic_load(sflag, __ATOMIC_RELAXED, __HIP_MEMORY_SCOPE_AGENT) < (unsigned)NS && ++sp < (1u << 22)) __builtin_amdgcn_s_sleep(2);
                    __builtin_amdgcn_fence(__ATOMIC_ACQUIRE, "agent"); asm volatile("s_waitcnt vmcnt(0)" ::: "memory"); }
                __syncthreads(); }
            skinny_gemm<0, 1>(lds, HNs, Wt, DM, DIN, 1, Zb + (size_t)MPROMPT * DIN, nullptr, nullptr, rsA + MPROMPT, bid, G);
        }
        SEAM(p);
        if (IN(p + 1)) {
            __syncthreads();
            unsigned* qctr = (unsigned*)(a.ws + WS_QCTR) + 64 * (2 * l);
            volatile LAS unsigned* qslot = (volatile LAS unsigned*)(lds + LDS_BYTES - 32);
            unsigned nxt = 0u;
            if (threadIdx.x == 0) nxt = __hip_atomic_fetch_add(qctr, 1u, __ATOMIC_RELAXED, __HIP_MEMORY_SCOPE_AGENT);
            for (;;) {
                if (threadIdx.x == 0) { qslot[0] = nxt; nxt = __hip_atomic_fetch_add(qctr, 1u, __ATOMIC_RELAXED, __HIP_MEMORY_SCOPE_AGENT); }
                __syncthreads();
                const int it = (int)qslot[0];
                __syncthreads();
                if (it >= 520 + 264 + 288) break;
                if (it < 520) { for (int rep = 0; rep < REP_A; ++rep) mixA_item(a, lds, l, it); }
                else if (it < 784) { for (int rep = 0; rep < REP_C; ++rep) mixC_item(a, lds, l, it - 520); }
                else { for (int rep = 0; rep < REP_B; ++rep) mixB_item(a, lds, l, it - 784); }
            }
        }
        SEAM(p + 1);
        if (IN(p + 2)) {
            for (int rep = 0; rep < REP_MIX; ++rep)
            for (int it = bid; it < 512; it += G) mixA2_item(a, lds, l, it);
        }
        SEAM(p + 2);
        if (IN(p + 3)) {
            const bf16_t* Wt = (const bf16_t*)(a.ws + WS_WOUT) + (size_t)l * DM * DM;
            pg8::Gemm g{MIXb, Wt, MPROMPT, DM, DM}; pg8::StaticOrder S; S.init(MPROMPT, DM, G, bid, WGM_G2);
            pg8::EpiResF32 E{l == 0 ? a.in[I_XP] : X, X, DM, HN, rsF};
            pg8::gemm_phase<pg8::EpiResF32, pg8::StaticOrder, true, true>(lds, g, S, E);
            skinny_gemm<3, 1>(lds, MIXb + (size_t)MPROMPT * DM, Wt, DM, DM, 1, HNs, l == 0 ? a.in[I_XS] : Xs, Xs, rsF + MPROMPT, bid, G);
        }
        SEAM(p + 3);
        if (IN(p + 4)) {
            const bf16_t* Wt = (const bf16_t*)(a.ws + WS_WFF1) + (size_t)l * DM * DFF;
            pg8::Gemm g{HN, Wt, MPROMPT, DFF, DM}; pg8::StaticOrder S; S.init(MPROMPT, DFF, G, bid, WGM_G3);
            pg8::EpiBf16<2> E{FFb, DFF, rsF, 1.0f / DM, EPS};
            pg8::gemm_phase<pg8::EpiBf16<2>, pg8::StaticOrder, true, true>(lds, g, S, E);
            skinny_gemm<2, 2>(lds, HNs, Wt, DM, DFF, 1, FFb + (size_t)MPROMPT * DFF, nullptr, nullptr, rsF + MPROMPT, bid, G);
        }
        SEAM(p + 4);
        if (IN(p + 5)) {
            const bf16_t* Wt = (const bf16_t*)(a.ws + WS_WFF2) + (size_t)l * DM * DFF;
            pg8::Gemm g{FFb, Wt, MPROMPT, DM, DFF}; pg8::StaticOrder S; S.init(MPROMPT, DM, G, bid, WGM_G4);
            const bool last = (l + 1 == DEPTH);
            pg8::EpiResF32 E{X, X, DM, last ? nullptr : HN, last ? nullptr : rsN};
            pg8::gemm_phase<pg8::EpiResF32, pg8::StaticOrder, true, true>(lds, g, S, E);
            if (FOLD_FLAG || last) skinny_gemm<4, 4>(lds, FFb + (size_t)MPROMPT * DFF, Wt, DFF, DM, 8, nullptr, nullptr, (float*)(a.ws + WS_PART), nullptr, bid, G);
            else skinny_gemm<3, 2>(lds, FFb + (size_t)MPROMPT * DFF, Wt, DFF, DM, 1, HNs, Xs, Xs, rsN + MPROMPT, bid, G);
        }
        SEAM(p + 5);
    }
    if (IN(1 + 6 * DEPTH)) phase_rms(X, Xs, a.in[I_NFIN], nullptr, a.out + O_YP, bid, NGW, (const float*)(a.ws + WS_PART), Xs);
#undef IN
#undef SEAM
}

#ifndef MK_PER_PHASE
#define MK_PER_PHASE 0
#endif
extern "C" void kernel_launch(void* const* d_in, const int* in_sizes, int n_in, void* d_out, int out_size, void* d_ws, size_t ws_size, hipStream_t stream) {
    static int grid = 0;
    if (grid == 0) {
        if (n_in != N_INPUTS || ws_size < WS_END) { fprintf(stderr, "kernel_launch: unexpected n_in %d / ws %zu\n", n_in, ws_size); grid = -1; return; }
        int dev = 0, cus = 0, per_cu = 0;
        (void)hipGetDevice(&dev); (void)hipDeviceGetAttribute(&cus, hipDeviceAttributeMultiprocessorCount, dev);
        if (hipFuncSetAttribute((const void*)mega_fwd, hipFuncAttributeMaxDynamicSharedMemorySize, LDS_BYTES) != hipSuccess) { fprintf(stderr, "kernel_launch: hipFuncSetAttribute failed\n"); grid = -1; return; }
        if (hipOccupancyMaxActiveBlocksPerMultiprocessor(&per_cu, (const void*)mega_fwd, 512, LDS_BYTES) != hipSuccess || per_cu < 1) per_cu = 1;
        (void)hipGetLastError();
        if (cus <= 0) cus = 256;
        grid = cus * per_cu;
    }
    if (grid < 0) return;
    if (hipMemsetAsync(d_ws, 0, 262144, stream) != hipSuccess) { fprintf(stderr, "kernel_launch: memset failed\n"); return; }
    Args a{};
    for (int i = 0; i < N_INPUTS; ++i) a.in[i] = (const float*)d_in[i];
    a.out = (float*)d_out; a.ws = (unsigned char*)d_ws;
#if MK_PER_PHASE
    for (int p = 0; p < N_PHASES; ++p) { a.ph_lo = p; a.ph_hi = p + 1; hipLaunchKernelGGL(mega_fwd, dim3(grid), dim3(512), LDS_BYTES, stream, a); }
#else
    a.ph_lo = 0; a.ph_hi = N_PHASES;
    void* kargs[] = {&a};
    hipError_t e = hipLaunchCooperativeKernel((const void*)mega_fwd, dim3(grid), dim3(512), kargs, LDS_BYTES, stream);
    if (e != hipSuccess) fprintf(stderr, "cooperative launch failed: %s (grid %d)\n", hipGetErrorString(e), grid);
#endif
}
```

```cpp
#include <hip/hip_runtime.h>
#include <hip/hip_cooperative_groups.h>
#include <cstdio>
#include <cstdint>
namespace cg = cooperative_groups;

namespace pg8 {
#define PG8_LAS __attribute__((address_space(3)))
typedef unsigned short bf16_t;
typedef short bf16x8 __attribute__((ext_vector_type(8)));
typedef float f32x4 __attribute__((ext_vector_type(4)));
typedef unsigned u32x4 __attribute__((ext_vector_type(4)));
constexpr int BM = 256, BK = 64, HALF = 128, HTB = HALF * BK * 2  , STAGE_BYTES = 8 * HTB, NXCD = 8, WGM = 8;

__host__ __device__ __forceinline__ int lds_byte(int r, int c) { const int st = (r >> 4) * 2 + (c >> 5), rr = r & 15, cc = c & 31, ob = rr * 64 + cc * 2; return st * 1024 + (ob ^ (((ob >> 9) & 1) << 5)); }
__host__ __device__ __forceinline__ void stage_rc(int b, int& R, int& C) { const int st = b / 1024, sb = b % 1024, swz = sb ^ (((sb >> 9) & 1) << 5); R = (st >> 1) * 16 + swz / 64; C = (st & 1) * 32 + (swz % 64) / 2; }
__host__ __device__ __forceinline__ int perm32(int rho) { const int n = rho >> 4, i = rho & 15; return 8 * (i >> 2) + 4 * n + (i & 3); }

struct Unit { int pm, pn; };
struct Gemm { const bf16_t* A; const bf16_t* Bt; int M, N, K; };

struct StaticOrder {
    int nM, nN, nwg, G, c, wgm;
    __host__ __device__ void init(int M, int N, int G_, int c_, int wgm_ = WGM) { nM = M / BM; nN = N / BM; nwg = nM * nN; G = G_; c = c_; wgm = wgm_; }
    __host__ __device__ bool next(int i, Unit& u) const {
        const long L = (long)i * G + c; if (L >= nwg) return false;
        int wgid = (int)L; { const int q = nwg / NXCD, r = nwg % NXCD, xcd = wgid % NXCD, off = wgid / NXCD; wgid = (xcd < r ? xcd * (q + 1) : r * (q + 1) + (xcd - r) * q) + off; }
        const int nig = wgm * nN, gid = wgid / nig, fm = gid * wgm, gsz = (nM - fm) < wgm ? (nM - fm) : wgm;
        u.pm = fm + ((wgid % nig) % gsz); u.pn = (wgid % nig) / gsz; return true;
    }
    __device__ __forceinline__ void a_ready(const Unit&) const {}
    __device__ __forceinline__ void done(const Unit&) const {}
};

__device__ __forceinline__ unsigned cvt_pk_bf16(float lo, float hi) { unsigned r; asm volatile("v_cvt_pk_bf16_f32 %0, %1, %2" : "=v"(r) : "v"(lo), "v"(hi)); return r; }

template <int ACT  > struct EpiBf16 {
    static constexpr bool PERM = true, AFTER_DRAIN = false;
    bf16_t* O; int ldc; const float* rss; float inv_k, eps;
    __device__ __forceinline__ void operator()(const f32x4 (&acc)[2][2][4][2], const Unit& u, int wr, int wc, int fr, int fq) const {
        const int row0 = u.pm * BM + wr * 64 + fr; const int col0 = u.pn * BM + wc * 32 + 8 * fq;
        float rs[2][4];
#pragma unroll
        for (int ai = 0; ai < 2; ++ai)
#pragma unroll
            for (int m = 0; m < 4; ++m) rs[ai][m] = rss[row0 + ai * HALF + m * 16];
        __builtin_amdgcn_sched_barrier(0);
#pragma unroll
        for (int ai = 0; ai < 2; ++ai)
#pragma unroll
            for (int m = 0; m < 4; ++m) { bf16_t* rowp = O + (size_t)(row0 + ai * HALF + m * 16) * ldc + col0;
                const float rstd = __builtin_amdgcn_rsqf(rs[ai][m] * inv_k + eps);
#pragma unroll
                for (int bj = 0; bj < 2; ++bj) { f32x4 v0 = acc[ai][bj][m][0] * rstd, v1 = acc[ai][bj][m][1] * rstd;
                    if (ACT == 2) {
#pragma unroll
                        for (int e = 0; e < 4; ++e) { float a = fmaxf(v0[e], 0.f), b = fmaxf(v1[e], 0.f); v0[e] = a * a; v1[e] = b * b; } }
                    u32x4 w; w.x = cvt_pk_bf16(v0[0], v0[1]); w.y = cvt_pk_bf16(v0[2], v0[3]); w.z = cvt_pk_bf16(v1[0], v1[1]); w.w = cvt_pk_bf16(v1[2], v1[3]);
                    *(u32x4*)(rowp + bj * HALF) = w; } }
    }
};
typedef unsigned u32x2_t __attribute__((ext_vector_type(2)));
struct EpiResF32 {
    static constexpr bool PERM = false, AFTER_DRAIN = false;
    const float* base; float* out; int ldc; bf16_t* xb; float* rss;
    __device__ __forceinline__ void operator()(const f32x4 (&acc)[2][2][4][2], const Unit& u, int wr, int wc, int fr, int fq) const {
        const int col0 = u.pn * BM + wc * 32 + 4 * fq;
#pragma unroll
        for (int ai = 0; ai < 2; ++ai) {
            f32x4 bs[4][2][2];
#pragma unroll
            for (int m = 0; m < 4; ++m) { const float* b = base + (size_t)(u.pm * BM + ai * HALF + wr * 64 + m * 16 + fr) * ldc + col0;
#pragma unroll
                for (int bj = 0; bj < 2; ++bj)
#pragma unroll
                    for (int n = 0; n < 2; ++n) bs[m][bj][n] = *(const f32x4*)(b + bj * HALF + n * 16); }
            __builtin_amdgcn_sched_barrier(0);
#pragma unroll
            for (int m = 0; m < 4; ++m) { const int r = u.pm * BM + ai * HALF + wr * 64 + m * 16 + fr; float* o = out + (size_t)r * ldc + col0; float ss = 0.f;
#pragma unroll
                for (int bj = 0; bj < 2; ++bj)
#pragma unroll
                    for (int n = 0; n < 2; ++n) { const f32x4 v = bs[m][bj][n] + acc[ai][bj][m][n]; *(f32x4*)(o + bj * HALF + n * 16) = v;
                        if (xb) { u32x2_t w; w.x = cvt_pk_bf16(v[0], v[1]); w.y = cvt_pk_bf16(v[2], v[3]); *(u32x2_t*)(xb + (size_t)r * ldc + col0 + bj * HALF + n * 16) = w; ss += (v[0] * v[0] + v[1] * v[1]) + (v[2] * v[2] + v[3] * v[3]); } }
                if (xb) { ss += __shfl_xor(ss, 16); ss += __shfl_xor(ss, 32); if (fq == 0) atomicAdd(rss + r, ss); } }
            __builtin_amdgcn_sched_barrier(0);
        }
    }
};

template <class Epi, class Sched, bool ALIGN_EPI = false, bool SP2 = false>
__device__ __forceinline__ void gemm_phase(PG8_LAS unsigned char* lds, const Gemm g, const Sched& S, const Epi& E) {
    int tid_ = threadIdx.x; asm volatile("" : "+v"(tid_));
    const int tid = tid_, wid = __builtin_amdgcn_readfirstlane(tid >> 6), lane = tid & 63, wr = wid >> 2, wc = wid & 3, fr = lane & 15, fq = lane >> 4;
    const int K = g.K, nt = K / BK;
    unsigned voffA[2], voffB[2];
#pragma unroll
    for (int i = 0; i < 2; ++i) { int R, C; stage_rc(tid * 16 + i * 8192, R, C); const int Rb = Epi::PERM ? ((R & ~31) + perm32(R & 31)) : R;
        voffA[i] = (unsigned)(R * K + C) * 2u; voffB[i] = (unsigned)(Rb * K + C) * 2u; }
    const size_t kstep = (size_t)(BK * 2);
    const size_t hstep = (size_t)HALF * K * 2;
    const size_t tstep = 2 * hstep;
    const unsigned ldsw = (unsigned)wid * 1024u;
    const int aoff = lds_byte(wr * 64 + fr, fq * 8), boff = lds_byte(wc * 32 + fr, fq * 8);
#define PG8_SA(b, h) (((b) * 2 + (h)) * HTB)
#define PG8_SB(b, h) ((4 + (b) * 2 + (h)) * HTB)
#define PG8_STAGE(bufoff, gbase, voff) do { _Pragma("unroll") for (int _i = 0; _i < 2; ++_i) \
        __builtin_amdgcn_global_load_lds((const unsigned*)((const char*)(gbase) + (voff)[_i]), (PG8_LAS unsigned*)(lds + (bufoff) + ldsw + _i * 8192), 16, 0, 0); } while (0)
#define PG8_LDA(dst, b, h) do { _Pragma("unroll") for (int m = 0; m < 4; ++m) _Pragma("unroll") for (int k = 0; k < 2; ++k) dst[m][k] = *(const PG8_LAS bf16x8*)(lds + PG8_SA(b, h) + aoff + m * 2048 + k * 1024); } while (0)
#define PG8_LDB(dst, b, h) do { _Pragma("unroll") for (int n = 0; n < 2; ++n) _Pragma("unroll") for (int k = 0; k < 2; ++k) dst[n][k] = *(const PG8_LAS bf16x8*)(lds + PG8_SB(b, h) + boff + n * 2048 + k * 1024); } while (0)
#define PG8_MMA(ai, bj, At, Bt) do { __builtin_amdgcn_s_setprio(1); _Pragma("unroll") for (int m = 0; m < 4; ++m) _Pragma("unroll") for (int n = 0; n < 2; ++n) _Pragma("unroll") for (int k = 0; k < 2; ++k) \
        acc[ai][bj][m][n] = __builtin_amdgcn_mfma_f32_16x16x32_bf16(Bt[n][k], At[m][k], acc[ai][bj][m][n], 0, 0, 0); __builtin_amdgcn_s_setprio(0); } while (0)
#define PG8_WAIT_V(n) asm volatile("s_waitcnt vmcnt(" #n ")" ::: "memory")
#define PG8_WAIT_L(n) asm volatile("s_waitcnt lgkmcnt(" #n ")" ::: "memory")
#define PG8_BAR __builtin_amdgcn_s_barrier()
#define PG8_SCHED __builtin_amdgcn_sched_barrier(0)
    Unit cur, nxt; int ui = 0;
    if (!S.next(0, cur)) return;
    f32x4 acc[2][2][4][2];
#pragma unroll
    for (int a = 0; a < 2; ++a)
#pragma unroll
        for (int b = 0; b < 2; ++b)
#pragma unroll
            for (int m = 0; m < 4; ++m)
#pragma unroll
                for (int n = 0; n < 2; ++n) acc[a][b][m][n] = (f32x4){0.f, 0.f, 0.f, 0.f};
    bf16x8 At[4][2], B0[2][2], B1[2][2];
    const char* cA = (const char*)g.A + (size_t)cur.pm * tstep; const char* cB = (const char*)g.Bt + (size_t)cur.pn * tstep;
    S.a_ready(cur);
    if constexpr (SP2) {
        PG8_STAGE(PG8_SB(0, 0), cB, voffB); PG8_STAGE(PG8_SB(0, 1), cB + hstep, voffB); PG8_STAGE(PG8_SA(0, 0), cA, voffA); PG8_STAGE(PG8_SA(0, 1), cA + hstep, voffA);
        if (wr == 1) PG8_BAR;
        PG8_WAIT_V(2); PG8_BAR;
        PG8_STAGE(PG8_SB(1, 0), cB + kstep, voffB); PG8_STAGE(PG8_SA(1, 0), cA + kstep, voffA); PG8_STAGE(PG8_SB(1, 1), cB + hstep + kstep, voffB);
        PG8_WAIT_V(6); PG8_BAR;
    } else {
        PG8_STAGE(PG8_SB(0, 0), cB, voffB); PG8_STAGE(PG8_SA(0, 0), cA, voffA); PG8_STAGE(PG8_SB(0, 1), cB + hstep, voffB); PG8_STAGE(PG8_SA(0, 1), cA + hstep, voffA);
        if (wr == 1) PG8_BAR;
        PG8_WAIT_V(4); PG8_BAR;
        PG8_STAGE(PG8_SB(1, 0), cB + kstep, voffB); PG8_STAGE(PG8_SA(1, 0), cA + kstep, voffA); PG8_STAGE(PG8_SB(1, 1), cB + hstep + kstep, voffB);
        PG8_WAIT_V(6); PG8_BAR;
    }
    for (;;) {
        const bool has_next = S.next(ui + 1, nxt);
        const char* nA = has_next ? (const char*)g.A + (size_t)nxt.pm * tstep : cA; const char* nB = has_next ? (const char*)g.Bt + (size_t)nxt.pn * tstep : cB;
        for (int t = 0; t < nt; t += 2) {
            const bool last = (t == nt - 2);
            const char* a1 = cA + (size_t)(t + 1) * kstep;
            const char* a2 = last ? nA : cA + (size_t)(t + 2) * kstep; const char* b2 = last ? nB : cB + (size_t)(t + 2) * kstep;
            const char* a3 = a2 + kstep; const char* b3 = b2 + kstep;
            if (last && has_next) S.a_ready(nxt);
            if constexpr (SP2) {
            PG8_LDB(B0, 0, 0); PG8_LDB(B1, 0, 1); PG8_SCHED; PG8_LDA(At, 0, 0); PG8_STAGE(PG8_SA(1, 1), a1 + hstep, voffA);
            PG8_WAIT_V(8); PG8_WAIT_L(0); PG8_BAR; PG8_MMA(0, 0, At, B0); PG8_MMA(0, 1, At, B1); PG8_BAR; PG8_SCHED;
            PG8_LDA(At, 0, 1); PG8_STAGE(PG8_SB(0, 0), b2, voffB); PG8_STAGE(PG8_SB(0, 1), b2 + hstep, voffB); PG8_STAGE(PG8_SA(0, 0), a2, voffA);
            PG8_WAIT_V(8); PG8_WAIT_L(0); PG8_BAR; PG8_MMA(1, 0, At, B0); PG8_MMA(1, 1, At, B1); PG8_BAR; PG8_SCHED;
            PG8_LDB(B0, 1, 0); PG8_LDB(B1, 1, 1); PG8_SCHED; PG8_LDA(At, 1, 0); PG8_STAGE(PG8_SA(0, 1), a2 + hstep, voffA);
            PG8_WAIT_V(8); PG8_WAIT_L(0); PG8_BAR; PG8_MMA(0, 0, At, B0); PG8_MMA(0, 1, At, B1); PG8_BAR; PG8_SCHED;
            PG8_LDA(At, 1, 1); PG8_STAGE(PG8_SB(1, 0), b3, voffB); PG8_STAGE(PG8_SB(1, 1), b3 + hstep, voffB); PG8_STAGE(PG8_SA(1, 0), a3, voffA);
            PG8_WAIT_V(8); PG8_WAIT_L(0); PG8_BAR; PG8_MMA(1, 0, At, B0); PG8_MMA(1, 1, At, B1); PG8_BAR; PG8_SCHED;
            } else {
            PG8_LDB(B0, 0, 0); PG8_SCHED; PG8_LDA(At, 0, 0); PG8_STAGE(PG8_SA(1, 1), a1 + hstep, voffA);
            PG8_WAIT_L(8); PG8_BAR; PG8_WAIT_L(0); PG8_MMA(0, 0, At, B0); PG8_BAR; PG8_SCHED;
            PG8_LDB(B1, 0, 1); PG8_STAGE(PG8_SB(0, 0), b2, voffB);
            PG8_BAR; PG8_WAIT_L(0); PG8_MMA(0, 1, At, B1); PG8_BAR;
            PG8_LDA(At, 0, 1); PG8_STAGE(PG8_SA(0, 0), a2, voffA);
            PG8_BAR; PG8_WAIT_L(0); PG8_MMA(1, 0, At, B0); PG8_BAR; PG8_SCHED;
            PG8_STAGE(PG8_SB(0, 1), b2 + hstep, voffB);
            PG8_WAIT_V(6); PG8_BAR; PG8_MMA(1, 1, At, B1); PG8_BAR;
            PG8_LDB(B0, 1, 0); PG8_SCHED; PG8_LDA(At, 1, 0); PG8_STAGE(PG8_SA(0, 1), a2 + hstep, voffA);
            PG8_WAIT_L(8); PG8_BAR; PG8_WAIT_L(0); PG8_MMA(0, 0, At, B0); PG8_BAR; PG8_SCHED;
            PG8_LDB(B1, 1, 1); PG8_STAGE(PG8_SB(1, 0), b3, voffB);
            PG8_BAR; PG8_WAIT_L(0); PG8_MMA(0, 1, At, B1); PG8_BAR;
            PG8_LDA(At, 1, 1); PG8_STAGE(PG8_SA(1, 0), a3, voffA);
            PG8_BAR; PG8_WAIT_L(0); PG8_MMA(1, 0, At, B0); PG8_BAR; PG8_SCHED;
            PG8_STAGE(PG8_SB(1, 1), b3 + hstep, voffB);
            PG8_WAIT_V(6); PG8_BAR; PG8_MMA(1, 1, At, B1); PG8_BAR;
            }
        }
        if constexpr (ALIGN_EPI) { if (wr == 0) PG8_BAR; }
        if constexpr (!Epi::AFTER_DRAIN) { E(acc, cur, wr, wc, fr, fq); S.done(cur); }
        if (!has_next) break;
#pragma unroll
        for (int a = 0; a < 2; ++a)
#pragma unroll
            for (int b = 0; b < 2; ++b)
#pragma unroll
                for (int m = 0; m < 4; ++m)
#pragma unroll
                    for (int n = 0; n < 2; ++n) acc[a][b][m][n] = (f32x4){0.f, 0.f, 0.f, 0.f};
        cur = nxt; cA = nA; cB = nB; ++ui;
        if constexpr (ALIGN_EPI) { if (wr == 1) PG8_BAR; }
    }
    PG8_WAIT_V(0);
    if constexpr (!ALIGN_EPI) { if (wr == 0) PG8_BAR; }
    PG8_BAR;
    if constexpr (Epi::AFTER_DRAIN) { E.fused(acc, cur, wr, wc, fr, fq, lds, wid, lane); S.done(cur); }
#undef PG8_SA
#undef PG8_SB
#undef PG8_STAGE
#undef PG8_LDA
#undef PG8_LDB
#undef PG8_MMA
#undef PG8_WAIT_V
#undef PG8_WAIT_L
#undef PG8_BAR
#undef PG8_SCHED
}
}

#define LAS __attribute__((address_space(3)))
typedef unsigned short bf16_t;
typedef short bf16x8 __attribute__((ext_vector_type(8)));
typedef float f32x4 __attribute__((ext_vector_type(4)));
typedef unsigned u32x4 __attribute__((ext_vector_type(4)));
typedef unsigned u32x2 __attribute__((ext_vector_type(2)));

constexpr int DM = 2048, NB = 4, SEQ = 2048, DEPTH = 2, NS = 128;
constexpr int MPROMPT = NB * SEQ, MV = MPROMPT + NS, MPAD = 8448;
constexpr int WA = 1024, WB = 512, WC = 512, KB = 31;
constexpr int DIN = 4096, DFF = 8192;
constexpr int ZXA = 0, ZGA = 1024, ZXB = 2048, ZGB = 2560, ZUC = 3072, ZVC = 3584;
constexpr int MYA = 0, MYB = 1024, MYC = 1536;
constexpr float EPS = 1e-6f;
constexpr size_t O_YP = 0, O_YS = 16777216, O_CAP = O_YS + 262144, O_HP = O_CAP + 24576, O_CBP = O_HP + 8192, O_CAS = O_CBP + 122880,
                 O_HS = O_CAS + 786432, O_CBS = O_HS + 262144, O_VS = O_CBS + 3932160;
enum { I_XP = 0, I_XS, I_SCA, I_SH, I_SCB, I_NMIX, I_WIN, I_CAW, I_CAB, I_GRW, I_GRB, I_GIW, I_GIB, I_LAM, I_CBW, I_LNBG, I_LNBB, I_SLG, I_SLB, I_SW, I_SB, I_WOUT, I_NFFN, I_WFF1, I_WFF2, I_NFIN, N_INPUTS };
constexpr size_t MiB = 1u << 20;
constexpr size_t WS_WIN = 1 * MiB, WS_WOUT = 33 * MiB, WS_WFF1 = 49 * MiB, WS_WFF2 = 113 * MiB, WS_GATE = 177 * MiB, WS_SGUW = 178 * MiB, WS_CARRY = 179 * MiB;
constexpr size_t WS_X = 180 * MiB, WS_HN = 246 * MiB, WS_Z = 279 * MiB, WS_MIX = 345 * MiB, WS_HLOC = 378 * MiB, WS_PCUM = 394 * MiB, WS_FF = 279 * MiB, WS_PART = 411 * MiB, WS_END = 419 * MiB, WS_QCTR = 16384, WS_RS = 65536;
constexpr int LDS_BYTES = 147456;

struct Args { const float* in[N_INPUTS]; float* out; unsigned char* ws; int ph_lo, ph_hi; };

__device__ __forceinline__ unsigned f2bf(float f) { unsigned u = __builtin_bit_cast(unsigned, f); return (u + 0x7fffu + ((u >> 16) & 1u)) >> 16; }
__device__ __forceinline__ unsigned pk2(float lo, float hi) { unsigned r; asm("v_cvt_pk_bf16_f32 %0, %1, %2" : "=v"(r) : "v"(lo), "v"(hi)); return r; }
__device__ __forceinline__ float bflo(unsigned w) { return __builtin_bit_cast(float, w << 16); }
__device__ __forceinline__ float bfhi(unsigned w) { return __builtin_bit_cast(float, w & 0xffff0000u); }
__device__ __forceinline__ float bf1(bf16_t h) { return __builtin_bit_cast(float, (unsigned)h << 16); }
__device__ __forceinline__ void unpack8(const u32x4 w, float (&v)[8]) { v[0] = bflo(w.x); v[1] = bfhi(w.x); v[2] = bflo(w.y); v[3] = bfhi(w.y); v[4] = bflo(w.z); v[5] = bfhi(w.z); v[6] = bflo(w.w); v[7] = bfhi(w.w); }
__device__ __forceinline__ u32x4 pack8(const float (&v)[8]) { u32x4 w; w.x = pk2(v[0], v[1]); w.y = pk2(v[2], v[3]); w.z = pk2(v[4], v[5]); w.w = pk2(v[6], v[7]); return w; }
__device__ __forceinline__ float frcp(float x) { return __builtin_amdgcn_rcpf(x); }
__device__ __forceinline__ float sigmoidf_(float x) { return frcp(1.0f + __expf(-x)); }
__device__ __forceinline__ float gelu_t(float x) { const float y = 1.5957691216f * (x + 0.044715f * x * x * x); return x * frcp(1.0f + __expf(-y)); }
__device__ __forceinline__ int opaque_tid() { int t = threadIdx.x; asm volatile("" : "+v"(t)); return t; }
__device__ __forceinline__ float wave_sum(float v) {
#pragma unroll
    for (int o = 1; o < 64; o <<= 1) v += __shfl_xor(v, o);
    return v;
}


__device__ __forceinline__ void transpose_item(const float* __restrict__ W, int K, int N, bf16_t* __restrict__ WT, LAS float* scr, int item, int lane, const float* __restrict__ gk = nullptr) {
    const int nblk = N >> 6, kb = item / nblk, nb = item - kb * nblk, k0 = kb << 6, n0 = nb << 6;
    const int rr = lane >> 4, c4 = (lane & 15) << 2;
#pragma unroll 4
    for (int i = 0; i < 16; ++i) { const int kk = 4 * i + rr; f32x4 v = *(const f32x4*)(W + (size_t)(k0 + kk) * N + n0 + c4); if (gk) v = v * gk[k0 + kk];
        scr[kk * 65 + c4 + 0] = v[0]; scr[kk * 65 + c4 + 1] = v[1]; scr[kk * 65 + c4 + 2] = v[2]; scr[kk * 65 + c4 + 3] = v[3]; }
    asm volatile("s_waitcnt lgkmcnt(0)" ::: "memory");
    const int c = lane & 7;
#pragma unroll
    for (int j = 0; j < 8; ++j) { const int n = (lane >> 3) + 8 * j; const LAS float* s = scr + (8 * c) * 65 + n;
        u32x4 o; o.x = pk2(s[0 * 65], s[1 * 65]); o.y = pk2(s[2 * 65], s[3 * 65]); o.z = pk2(s[4 * 65], s[5 * 65]); o.w = pk2(s[6 * 65], s[7 * 65]);
        *(u32x4*)(WT + (size_t)(n0 + n) * K + k0 + 8 * c) = o; }
    asm volatile("s_waitcnt lgkmcnt(0)" ::: "memory");
}

__device__ __forceinline__ void phase_prep(const Args& a, LAS unsigned char* lds, int bid, int NGW) {
    const int tid = opaque_tid(), lane = tid & 63, wave = __builtin_amdgcn_readfirstlane(tid >> 6), gw = bid * 8 + wave;
    LAS float* scr = (LAS float*)(lds + wave * 16640);
    constexpr int I_IN = (DM / 64) * (DIN / 64), I_OUT = (DM / 64) * (DM / 64), I_F1 = (DM / 64) * (DFF / 64), I_F2 = (DFF / 64) * (DM / 64), I_G = 2 * 8 * 4;
    constexpr int PER_LAYER = I_IN + I_OUT + I_F1 + I_F2 + I_G;
    for (int it = gw; it < DEPTH * PER_LAYER; it += NGW) {
        const int l = it / PER_LAYER; int r = it - l * PER_LAYER;
        if (r < I_IN) { transpose_item(a.in[I_WIN] + (size_t)l * DM * DIN, DM, DIN, (bf16_t*)(a.ws + WS_WIN) + (size_t)l * DM * DIN, scr, r, lane, a.in[I_NMIX] + (size_t)l * DM); continue; } r -= I_IN;
        if (r < I_OUT) { transpose_item(a.in[I_WOUT] + (size_t)l * DM * DM, DM, DM, (bf16_t*)(a.ws + WS_WOUT) + (size_t)l * DM * DM, scr, r, lane); continue; } r -= I_OUT;
        if (r < I_F1) { transpose_item(a.in[I_WFF1] + (size_t)l * DM * DFF, DM, DFF, (bf16_t*)(a.ws + WS_WFF1) + (size_t)l * DM * DFF, scr, r, lane, a.in[I_NFFN] + (size_t)l * DM); continue; } r -= I_F1;
        if (r < I_F2) { transpose_item(a.in[I_WFF2] + (size_t)l * DM * DFF, DFF, DM, (bf16_t*)(a.ws + WS_WFF2) + (size_t)l * DM * DFF, scr, r, lane); continue; } r -= I_F2;
        { const int g = r >> 5, h = (r >> 2) & 7, sub = r & 3;
          const float* src = (g ? a.in[I_GIW] : a.in[I_GRW]) + ((size_t)l * 8 + h) * 16384;
          bf16_t* dst = (bf16_t*)(a.ws + WS_GATE) + (((size_t)l * 2 + g) * 8 + h) * 16384;
          transpose_item(src, 128, 128, dst, scr, sub, lane); }
    }
    const float* sw = a.in[I_SW]; bf16_t* so = (bf16_t*)(a.ws + WS_SGUW);
    for (int i = gw * 64 + lane; i < DEPTH * 4 * 128 * 128; i += NGW * 64) { const int s = i & 127, t = (i >> 7) & 127; so[i] = (bf16_t)(s <= t ? f2bf(sw[i]) : 0u); }
}

__device__ __forceinline__ void phase_rms(const float* xp, const float* xs, const float* __restrict__ g, bf16_t* obf, float* of32, int bid, int NGW, const float* part = nullptr, float* xs_wb = nullptr, float* rss_out = nullptr) {
#ifdef DIS_R
    return;
#endif
    const int tid = opaque_tid(), lane = tid & 63, gw = bid * 8 + __builtin_amdgcn_readfirstlane(tid >> 6);
    f32x4 gv[8];
#pragma unroll
    for (int j = 0; j < 8; ++j) gv[j] = ((const f32x4*)g)[lane + 64 * j];
    for (int r = gw; r < MV; r += NGW) {
        const f32x4* xr = (const f32x4*)(r < MPROMPT ? xp + (size_t)r * DM : xs + (size_t)(r - MPROMPT) * DM);
        f32x4 v[8]; float ss = 0.f;
#pragma unroll
        for (int j = 0; j < 8; ++j) v[j] = xr[lane + 64 * j];
        if (part && r >= MPROMPT) {
#pragma unroll 1
            for (int ks = 0; ks < 8; ks += 2) { const f32x4* pr = (const f32x4*)(part + ((size_t)ks * NS + (r - MPROMPT)) * DM); const f32x4* pr2 = pr + (size_t)NS * DM / 4;
                f32x4 t0[8], t1[8];
#pragma unroll
                for (int j = 0; j < 8; ++j) { t0[j] = pr[lane + 64 * j]; t1[j] = pr2[lane + 64 * j]; }
                __builtin_amdgcn_sched_barrier(0);
#pragma unroll
                for (int j = 0; j < 8; ++j) v[j] += t0[j] + t1[j]; }
            f32x4* wb = (f32x4*)(xs_wb + (size_t)(r - MPROMPT) * DM);
#pragma unroll
            for (int j = 0; j < 8; ++j) wb[lane + 64 * j] = v[j];
        }
#pragma unroll
        for (int j = 0; j < 8; ++j) ss += (v[j][0] * v[j][0] + v[j][1] * v[j][1]) + (v[j][2] * v[j][2] + v[j][3] * v[j][3]);
        ss = wave_sum(ss);
        if (rss_out) {
            u32x2* o = (u32x2*)(obf + (size_t)r * DM);
#pragma unroll
            for (int j = 0; j < 8; ++j) { u32x2 w; w.x = pk2(v[j][0], v[j][1]); w.y = pk2(v[j][2], v[j][3]); o[lane + 64 * j] = w; }
            if (lane == 0) rss_out[r] = ss;
            continue;
        }
        const float rstd = 1.0f / sqrtf(ss * (1.0f / DM) + EPS);
        if (obf) { u32x2* o = (u32x2*)(obf + (size_t)r * DM);
#pragma unroll
            for (int j = 0; j < 8; ++j) { const f32x4 y = v[j] * rstd * gv[j]; u32x2 w; w.x = pk2(y[0], y[1]); w.y = pk2(y[2], y[3]); o[lane + 64 * j] = w; }
        } else { f32x4* o = (f32x4*)(of32 + (size_t)r * DM);
#pragma unroll
            for (int j = 0; j < 8; ++j) o[lane + 64 * j] = v[j] * rstd * gv[j]; }
    }
}

__device__ __forceinline__ void mixA_item(const Args& a, LAS unsigned char* lds, int l, int item) {
    const int tid = opaque_tid(), lane = tid & 63, wid = __builtin_amdgcn_readfirstlane(tid >> 6);
    const bool samp = item >= 512;
    const int tt = samp ? 64 : (item >> 3), h = samp ? (item - 512) : (item & 7);
    const int ti = tt & 15, r0 = tt * 128, c0 = h * 128, bseq = tt >> 4;
    const bf16_t* Z = (const bf16_t*)(a.ws + WS_Z);
    LAS bf16_t* AT = (LAS bf16_t*)lds;
    LAS float* AA = (LAS float*)lds;
    LAS float* UU = (LAS float*)(lds + 67584);
    LAS float* SP = (LAS float*)(lds + 135168);
    LAS float* SH = SP + 512;
    LAS float* CP = SH + 512;
    LAS float* CH = CP + 512;
    const float* caw = a.in[I_CAW] + (size_t)l * 4 * WA; const float* cab = a.in[I_CAB] + (size_t)l * WA;
    const int fr = lane & 15, fq = lane >> 4;
    bf16x8 gbr[4], gbi[4]; float brb_c, bib_c, lam_c;
    { const bf16_t* GR = (const bf16_t*)(a.ws + WS_GATE) + (((size_t)l * 2 + 0) * 8 + h) * 16384 + (size_t)(16 * wid + fr) * 128 + fq * 8;
      const bf16_t* GI = (const bf16_t*)(a.ws + WS_GATE) + (((size_t)l * 2 + 1) * 8 + h) * 16384 + (size_t)(16 * wid + fr) * 128 + fq * 8;
#pragma unroll
      for (int ks = 0; ks < 4; ++ks) { gbr[ks] = *(const bf16x8*)(GR + ks * 32); gbi[ks] = *(const bf16x8*)(GI + ks * 32); }
      const int c = c0 + 16 * wid + fr; brb_c = a.in[I_GRB][(size_t)l * WA + c]; bib_c = a.in[I_GIB][(size_t)l * WA + c]; lam_c = a.in[I_LAM][(size_t)l * WA + c]; }
    {
        const int kc = (tid & 15) * 8, c = c0 + kc, tb = tid >> 4;
        float wv[4][8], bias[8];
        { const f32x4 b0 = *(const f32x4*)(cab + c), b1 = *(const f32x4*)(cab + c + 4);
#pragma unroll
          for (int e = 0; e < 4; ++e) { bias[e] = b0[e]; bias[4 + e] = b1[e]; }
#pragma unroll
          for (int j = 0; j < 4; ++j) { const f32x4 w0 = *(const f32x4*)(caw + (size_t)j * WA + c), w1 = *(const f32x4*)(caw + (size_t)j * WA + c + 4);
#pragma unroll
              for (int e = 0; e < 4; ++e) { wv[j][e] = w0[e]; wv[j][4 + e] = w1[e]; } } }
        if (!samp) {
            u32x4 zr[4][4];
#pragma unroll
            for (int i = 0; i < 4; ++i)
#pragma unroll
                for (int j = 0; j < 4; ++j) { const int tr = tb + 32 * i - 3 + j; const int trc = (ti * 128 + tr >= 0) ? tr : 0;
                    zr[i][j] = *(const u32x4*)(Z + (size_t)(r0 + trc) * DIN + ZXA + c); }
            __builtin_amdgcn_sched_barrier(0);
#pragma unroll
            for (int i = 0; i < 4; ++i) { const int t = tb + 32 * i; float acc[8];
#pragma unroll
                for (int e = 0; e < 8; ++e) acc[e] = bias[e];
#pragma unroll
                for (int j = 0; j < 4; ++j) { float xv[8]; unpack8(zr[i][j], xv); const float msk = (ti * 128 + t - 3 + j >= 0) ? 1.f : 0.f;
#pragma unroll
                    for (int e = 0; e < 8; ++e) acc[e] += wv[j][e] * (xv[e] * msk);
                    if (j == 3 && ti == 15 && t >= 125) { float* o = a.out + O_CAP + (((size_t)l * NB + bseq) * 3 + (t - 125)) * WA + c;
                        *(f32x4*)o = (f32x4){xv[0], xv[1], xv[2], xv[3]}; *(f32x4*)(o + 4) = (f32x4){xv[4], xv[5], xv[6], xv[7]}; } }
                *(LAS u32x4*)(AT + t * 136 + kc) = pack8(acc); }
        } else {
            u32x4 zr[4]; f32x4 sv[4][3][2];
#pragma unroll
            for (int i = 0; i < 4; ++i) { const int t = tb + 32 * i; zr[i] = *(const u32x4*)(Z + (size_t)(MPROMPT + t) * DIN + ZXA + c);
#pragma unroll
                for (int j = 0; j < 3; ++j) { const float* sp = a.in[I_SCA] + (((size_t)l * NS + t) * 3 + j) * WA + c; sv[i][j][0] = *(const f32x4*)sp; sv[i][j][1] = *(const f32x4*)(sp + 4); } }
            __builtin_amdgcn_sched_barrier(0);
#pragma unroll
            for (int i = 0; i < 4; ++i) { const int t = tb + 32 * i; float acc[8];
#pragma unroll
                for (int e = 0; e < 8; ++e) acc[e] = bias[e];
#pragma unroll
                for (int j = 0; j < 4; ++j) { float xv[8];
                    if (j < 3) {
#pragma unroll
                        for (int e = 0; e < 4; ++e) { xv[e] = sv[i][j][0][e]; xv[4 + e] = sv[i][j][1][e]; } }
                    else unpack8(zr[i], xv);
#pragma unroll
                    for (int e = 0; e < 8; ++e) acc[e] += wv[j][e] * xv[e];
                    if (j >= 1) { float* o = a.out + O_CAS + (((size_t)l * NS + t) * 3 + (j - 1)) * WA + c;
                        *(f32x4*)o = (f32x4){xv[0], xv[1], xv[2], xv[3]}; *(f32x4*)(o + 4) = (f32x4){xv[4], xv[5], xv[6], xv[7]}; } }
                *(LAS u32x4*)(AT + t * 136 + kc) = pack8(acc); }
        }
    }
    __syncthreads();
    f32x4 accr[8], acci[8];
#pragma unroll
    for (int m = 0; m < 8; ++m) { accr[m] = (f32x4){0.f, 0.f, 0.f, 0.f}; acci[m] = (f32x4){0.f, 0.f, 0.f, 0.f}; }
#pragma unroll
    for (int ks = 0; ks < 4; ++ks) {
#pragma unroll
        for (int m = 0; m < 8; ++m) {
            const bf16x8 af = *(const LAS bf16x8*)(AT + (16 * m + fr) * 136 + ks * 32 + fq * 8);
            accr[m] = __builtin_amdgcn_mfma_f32_16x16x32_bf16(af, gbr[ks], accr[m], 0, 0, 0);
            acci[m] = __builtin_amdgcn_mfma_f32_16x16x32_bf16(af, gbi[ks], acci[m], 0, 0, 0);
        }
    }
    {
        const float LP = -8.0f * log1pf(expf(-lam_c));
#pragma unroll
        for (int m = 0; m < 8; ++m) {
#pragma unroll
            for (int j = 0; j < 4; ++j) {
                const int t = 16 * m + 4 * fq + j;
                const float xc = bf1(AT[t * 136 + 16 * wid + fr]);
                const float rg = sigmoidf_(accr[m][j] + brb_c), ig = sigmoidf_(acci[m][j] + bib_c);
                const float la = rg * LP, x2 = 2.0f * la;
                const float av = __expf(la);
                const float ser = -x2 * (1.0f + x2 * (0.5f + x2 * (0.16666667f + x2 * (0.041666668f + x2 * (0.0083333338f + x2 * 0.0013888889f)))));
                const float om = x2 > -0.25f ? ser : 1.0f - av * av;
                accr[m][j] = av;
                acci[m][j] = __builtin_amdgcn_sqrtf(om) * (ig * xc);
            }
        }
    }
    __syncthreads();
#pragma unroll
    for (int m = 0; m < 8; ++m)
#pragma unroll
        for (int j = 0; j < 4; ++j) { const int t = 16 * m + 4 * fq + j; AA[t * 132 + 16 * wid + fr] = accr[m][j]; UU[t * 132 + 16 * wid + fr] = acci[m][j]; }
    __syncthreads();
    if (!samp) {
        { const int k = tid & 127, seg = tid >> 7; float P = 1.f, hl = 0.f;
#pragma unroll 8
          for (int q = 0; q < 32; ++q) { const int t = 32 * seg + q; const float av = AA[t * 132 + k], uv = UU[t * 132 + k]; P *= av; hl = av * hl + uv; AA[t * 132 + k] = P; UU[t * 132 + k] = hl; }
          SP[seg * 128 + k] = P; SH[seg * 128 + k] = hl;
          __syncthreads();
          float Pc = 1.f, Hc = 0.f;
          for (int s = 0; s < seg; ++s) { const float ps = SP[s * 128 + k], hs = SH[s * 128 + k]; Hc = ps * Hc + hs; Pc *= ps; }
          CP[seg * 128 + k] = Pc; CH[seg * 128 + k] = Hc;
          if (seg == 3) { float* ca = (float*)(a.ws + WS_CARRY); ca[(size_t)tt * WA + c0 + k] = Pc * P; ca[(size_t)(64 + tt) * WA + c0 + k] = P * Hc + hl; }
          __syncthreads(); }
        bf16_t* HL = (bf16_t*)(a.ws + WS_HLOC); bf16_t* PL = (bf16_t*)(a.ws + WS_PCUM);
#pragma unroll
        for (int i = 0; i < 4; ++i) {
            const int chunk = tid + 512 * i, t = chunk >> 4, kc = (chunk & 15) * 8, sg = t >> 5;
            float hv[8], pv[8];
            const f32x4 p0 = *(const LAS f32x4*)(AA + t * 132 + kc), p1 = *(const LAS f32x4*)(AA + t * 132 + kc + 4), h0 = *(const LAS f32x4*)(UU + t * 132 + kc), h1 = *(const LAS f32x4*)(UU + t * 132 + kc + 4);
            const f32x4 cp0 = *(const LAS f32x4*)(CP + sg * 128 + kc), cp1 = *(const LAS f32x4*)(CP + sg * 128 + kc + 4), ch0 = *(const LAS f32x4*)(CH + sg * 128 + kc), ch1 = *(const LAS f32x4*)(CH + sg * 128 + kc + 4);
#pragma unroll
            for (int e = 0; e < 4; ++e) { hv[e] = h0[e] + p0[e] * ch0[e]; pv[e] = p0[e] * cp0[e]; hv[4 + e] = h1[e] + p1[e] * ch1[e]; pv[4 + e] = p1[e] * cp1[e]; }
            *(u32x4*)(HL + (size_t)(r0 + t) * WA + c0 + kc) = pack8(hv);
            *(u32x4*)(PL + (size_t)(r0 + t) * WA + c0 + kc) = pack8(pv);
        }
    } else {
        bf16_t* MIX = (bf16_t*)(a.ws + WS_MIX);
#pragma unroll
        for (int i = 0; i < 4; ++i) {
            const int chunk = tid + 512 * i, b = chunk >> 4, kc = (chunk & 15) * 8, c = c0 + kc;
            const float* h0 = a.in[I_SH] + ((size_t)l * NS + b) * WA + c; const f32x4 h00 = *(const f32x4*)h0, h01 = *(const f32x4*)(h0 + 4);
            float ga[8]; unpack8(*(const u32x4*)(Z + (size_t)(MPROMPT + b) * DIN + ZGA + c), ga);
            float hv[8], yv[8];
#pragma unroll
            for (int e = 0; e < 8; ++e) { const float hp = e < 4 ? h00[e & 3] : h01[e & 3]; hv[e] = AA[b * 132 + kc + e] * hp + UU[b * 132 + kc + e]; yv[e] = hv[e] * gelu_t(ga[e]); }
            float* ho = a.out + O_HS + ((size_t)l * NS + b) * WA + c;
            *(f32x4*)ho = (f32x4){hv[0], hv[1], hv[2], hv[3]}; *(f32x4*)(ho + 4) = (f32x4){hv[4], hv[5], hv[6], hv[7]};
            *(u32x4*)(MIX + (size_t)(MPROMPT + b) * DM + MYA + c) = pack8(yv);
        }
    }
    __syncthreads();
}

__device__ __forceinline__ void mixA2_item(const Args& a, LAS unsigned char* lds, int l, int item) {
    const int tid = opaque_tid();
    const int tt = item >> 3, h = item & 7, ti = tt & 15, r0 = tt * 128, c0 = h * 128, bseq = tt >> 4;
    LAS float* HIN = (LAS float*)lds;
    const float* ca = (const float*)(a.ws + WS_CARRY);
    if (tid < 128) { float Hc = 0.f; float ca_[15], ch_[15];
#pragma unroll
        for (int j = 0; j < 15; ++j) { const int t2 = tt - ti + (j < ti ? j : 0); ca_[j] = ca[(size_t)t2 * WA + c0 + tid]; ch_[j] = ca[(size_t)(64 + t2) * WA + c0 + tid]; }
        __builtin_amdgcn_sched_barrier(0);
#pragma unroll
        for (int j = 0; j < 15; ++j) { const float aj = j < ti ? ca_[j] : 1.f, hj = j < ti ? ch_[j] : 0.f; Hc = aj * Hc + hj; }
        HIN[tid] = Hc;
        if (ti == 15) a.out[O_HP + ((size_t)l * NB + bseq) * WA + c0 + tid] = ca[(size_t)tt * WA + c0 + tid] * Hc + ca[(size_t)(64 + tt) * WA + c0 + tid]; }
    __syncthreads();
    const bf16_t* Z = (const bf16_t*)(a.ws + WS_Z); const bf16_t* HL = (const bf16_t*)(a.ws + WS_HLOC); const bf16_t* PL = (const bf16_t*)(a.ws + WS_PCUM); bf16_t* MIX = (bf16_t*)(a.ws + WS_MIX);
    {   const int kc = (tid & 15) * 8, c = c0 + kc, tb = tid >> 4;
        u32x4 hr[4], pr[4], gr[4];
#pragma unroll
        for (int i = 0; i < 4; ++i) { const size_t row = (size_t)(r0 + tb + 32 * i); hr[i] = *(const u32x4*)(HL + row * WA + c); pr[i] = *(const u32x4*)(PL + row * WA + c); gr[i] = *(const u32x4*)(Z + row * DIN + ZGA + c); }
        __builtin_amdgcn_sched_barrier(0);
#pragma unroll
        for (int i = 0; i < 4; ++i) { float hv[8], pv[8], ga[8], yv[8]; unpack8(hr[i], hv); unpack8(pr[i], pv); unpack8(gr[i], ga);
#pragma unroll
            for (int e = 0; e < 8; ++e) yv[e] = (hv[e] + pv[e] * HIN[kc + e]) * gelu_t(ga[e]);
            *(u32x4*)(MIX + (size_t)(r0 + tb + 32 * i) * DM + MYA + c) = pack8(yv); }
    }
    __syncthreads();
}

__device__ __forceinline__ void lnB_rows(const Args& a, LAS float* Y, int l, int ntok, int row0, int wid, int lane) {
    const float* g = a.in[I_LNBG] + (size_t)l * WB; const float* bb = a.in[I_LNBB] + (size_t)l * WB; bf16_t* MIX = (bf16_t*)(a.ws + WS_MIX);
    float gg[8], bv[8];
#pragma unroll
    for (int i = 0; i < 8; ++i) { gg[i] = g[lane + 64 * i]; bv[i] = bb[lane + 64 * i]; }
    __builtin_amdgcn_sched_barrier(0);
    if (ntok == 32) {
        float v[4][8], s[4], q[4];
#pragma unroll
        for (int k = 0; k < 4; ++k) { s[k] = 0.f;
#pragma unroll
            for (int i = 0; i < 8; ++i) { v[k][i] = Y[(wid + 8 * k) * 512 + lane + 64 * i]; s[k] += v[k][i]; } }
#pragma unroll
        for (int o = 1; o < 64; o <<= 1) {
#pragma unroll
            for (int k = 0; k < 4; ++k) s[k] += __shfl_xor(s[k], o); }
#pragma unroll
        for (int k = 0; k < 4; ++k) { const float mean = s[k] * (1.0f / WB); q[k] = 0.f;
#pragma unroll
            for (int i = 0; i < 8; ++i) { v[k][i] -= mean; q[k] += v[k][i] * v[k][i]; } }
#pragma unroll
        for (int o = 1; o < 64; o <<= 1) {
#pragma unroll
            for (int k = 0; k < 4; ++k) q[k] += __shfl_xor(q[k], o); }
#pragma unroll
        for (int k = 0; k < 4; ++k) { const float rstd = 1.0f / sqrtf(q[k] * (1.0f / WB) + EPS);
#pragma unroll
            for (int i = 0; i < 8; ++i) { const int c = lane + 64 * i; const float o = v[k][i] * rstd * gg[i] + bv[i]; MIX[(size_t)(row0 + wid + 8 * k) * DM + MYB + c] = (bf16_t)f2bf(o * sigmoidf_(o)); } }
        return;
    }
    for (int t = wid; t < ntok; t += 8) {
        float v[8]; float s = 0.f;
#pragma unroll
        for (int i = 0; i < 8; ++i) { v[i] = Y[t * 512 + lane + 64 * i]; s += v[i]; }
        const float mean = wave_sum(s) * (1.0f / WB); float q = 0.f;
#pragma unroll
        for (int i = 0; i < 8; ++i) { v[i] -= mean; q += v[i] * v[i]; }
        const float rstd = 1.0f / sqrtf(wave_sum(q) * (1.0f / WB) + EPS);
#pragma unroll
        for (int i = 0; i < 8; ++i) { const int c = lane + 64 * i; const float o = v[i] * rstd * gg[i] + bv[i]; MIX[(size_t)(row0 + t) * DM + MYB + c] = (bf16_t)f2bf(o * sigmoidf_(o)); }
    }
}
__device__ __forceinline__ void mixB_item(const Args& a, LAS unsigned char* lds, int l, int item) {
    const int tid = opaque_tid(), lane = tid & 63, wid = __builtin_amdgcn_readfirstlane(tid >> 6);
    const bf16_t* Z = (const bf16_t*)(a.ws + WS_Z);
    LAS float* Y = (LAS float*)lds;
    const int c = tid;
    float w[31];
#pragma unroll
    for (int j = 0; j < 31; ++j) w[j] = a.in[I_CBW][((size_t)l * KB + j) * WB + c];
    if (item < 256) {
        const int bseq = item >> 6, tq = item & 63, r0 = item * 32;
        float ub[62];
        { bf16_t xr[62], gr[62];
#pragma unroll
          for (int k = 0; k < 62; ++k) { const int pos = tq * 32 + k - 30; const size_t ro = (size_t)(bseq * SEQ + (pos >= 0 ? pos : 0)) * DIN; xr[k] = Z[ro + ZXB + c]; gr[k] = Z[ro + ZGB + c]; }
          __builtin_amdgcn_sched_barrier(0);
#pragma unroll
          for (int k = 0; k < 62; ++k) { const int pos = tq * 32 + k - 30; const float v = bf1(xr[k]) * sigmoidf_(bf1(gr[k])); ub[k] = pos >= 0 ? v : 0.f; } }
#pragma unroll
        for (int t = 0; t < 32; ++t) { float y = 0.f;
#pragma unroll
            for (int j = 0; j < 31; ++j) y += w[j] * ub[t + j];
            Y[t * 512 + c] = y; }
        if (tq == 63) {
#pragma unroll
            for (int j = 0; j < 30; ++j) a.out[O_CBP + (((size_t)l * NB + bseq) * 30 + j) * WB + c] = ub[32 + j]; }
        __syncthreads();
        lnB_rows(a, Y, l, 32, r0, wid, lane);
    } else {
        const int is = item - 256;
#pragma unroll 1
        for (int q = 0; q < 4; ++q) {
            const int b = is * 4 + q; float y = 0.f;
            const float* st = a.in[I_SCB] + ((size_t)l * NS + b) * 30 * WB + c; float* co = a.out + O_CBS + ((size_t)l * NS + b) * 30 * WB + c;
            float sv[30];
#pragma unroll
            for (int j = 0; j < 30; ++j) sv[j] = st[(size_t)j * WB];
            const size_t ro = (size_t)(MPROMPT + b) * DIN; const bf16_t xbr = Z[ro + ZXB + c], gbr = Z[ro + ZGB + c];
            __builtin_amdgcn_sched_barrier(0);
#pragma unroll
            for (int j = 0; j < 30; ++j) { y += w[j] * sv[j]; if (j >= 1) co[(size_t)(j - 1) * WB] = sv[j]; }
            const float un = bf1(xbr) * sigmoidf_(bf1(gbr));
            y += w[30] * un; co[(size_t)29 * WB] = un;
            Y[q * 512 + c] = y;
        }
        __syncthreads();
        lnB_rows(a, Y, l, 4, MPROMPT + is * 4, wid, lane);
    }
    __syncthreads();
}

__device__ __forceinline__ void mixC_item(const Args& a, LAS unsigned char* lds, int l, int item) {
    const int tid = opaque_tid(), lane = tid & 63, wid = __builtin_amdgcn_readfirstlane(tid >> 6);
    const bf16_t* Z = (const bf16_t*)(a.ws + WS_Z); bf16_t* MIX = (bf16_t*)(a.ws + WS_MIX);
    const float* lg = a.in[I_SLG] + (size_t)l * WC; const float* lb = a.in[I_SLB] + (size_t)l * WC;
    if (item < 256) {
        const int tt = item >> 2, h = item & 3, r0 = tt * 128;
        LAS float* ST = (LAS float*)lds;
        LAS bf16_t* VT = (LAS bf16_t*)(lds + 1024);
        {
            u32x4 zr[16];
#pragma unroll
            for (int tk = 0; tk < 16; ++tk) zr[tk] = *(const u32x4*)(Z + (size_t)(r0 + 16 * wid + tk) * DIN + ZVC + lane * 8);
            __builtin_amdgcn_sched_barrier(0);
            float s1[16], s2[16];
#pragma unroll
            for (int tk = 0; tk < 16; ++tk) { float v[8]; unpack8(zr[tk], v); float p = 0.f, q = 0.f;
#pragma unroll
                for (int e = 0; e < 8; ++e) { const float gv = gelu_t(v[e]); p += gv; q += gv * gv; }
                s1[tk] = p; s2[tk] = q; }
#pragma unroll
            for (int o = 1; o < 64; o <<= 1) {
#pragma unroll
                for (int tk = 0; tk < 16; ++tk) { s1[tk] += __shfl_xor(s1[tk], o); s2[tk] += __shfl_xor(s2[tk], o); } }
#pragma unroll
            for (int tk = 0; tk < 16; ++tk) if (lane == tk) { const float mean = s1[tk] * (1.0f / WC); const float var = fmaxf(s2[tk] * (1.0f / WC) - mean * mean, 0.f);
                ST[2 * (16 * wid + tk)] = mean; ST[2 * (16 * wid + tk) + 1] = 1.0f / sqrtf(var + EPS); }
        }
        __syncthreads();
        {   const int dc = (tid & 15) * 8, cc = h * 128 + dc, sb = tid >> 4;
            u32x4 zr[4];
#pragma unroll
            for (int i = 0; i < 4; ++i) zr[i] = *(const u32x4*)(Z + (size_t)(r0 + sb + 32 * i) * DIN + ZVC + cc);
            __builtin_amdgcn_sched_barrier(0);
            const f32x4 g0 = *(const f32x4*)(lg + cc), g1 = *(const f32x4*)(lg + cc + 4), b0 = *(const f32x4*)(lb + cc), b1 = *(const f32x4*)(lb + cc + 4);
#pragma unroll
            for (int i = 0; i < 4; ++i) { const int s = sb + 32 * i; float v[8]; unpack8(zr[i], v);
                const float mean = ST[2 * s], rstd = ST[2 * s + 1];
#pragma unroll
                for (int e = 0; e < 8; ++e) { const float gg = e < 4 ? g0[e & 3] : g1[e & 3], bv = e < 4 ? b0[e & 3] : b1[e & 3];
                    VT[(dc + e) * 136 + (s ^ ((tid & 15) << 3))] = (bf16_t)f2bf((gelu_t(v[e]) - mean) * rstd * gg + bv); } }
        }
        __syncthreads();
        const int fr = lane & 15, fq = lane >> 4;
        f32x4 acc[8];
#pragma unroll
        for (int n = 0; n < 8; ++n) acc[n] = (f32x4){0.f, 0.f, 0.f, 0.f};
        const bf16_t* SW = (const bf16_t*)(a.ws + WS_SGUW) + ((size_t)l * 4 + h) * 16384;
        const int nks = (16 * wid + 16 + 31) >> 5;
        for (int ks = 0; ks < nks; ++ks) {
            const bf16x8 wf = *(const bf16x8*)(SW + (size_t)(16 * wid + fr) * 128 + ks * 32 + fq * 8);
#pragma unroll
            for (int n = 0; n < 8; ++n) { const bf16x8 vf = *(const LAS bf16x8*)(VT + (n * 16 + fr) * 136 + (((ks * 4 + fq) ^ (2 * n + (fr >> 3))) << 3));
                acc[n] = __builtin_amdgcn_mfma_f32_16x16x32_bf16(vf, wf, acc[n], 0, 0, 0); }
        }
        const int t = 16 * wid + fr; const float bs = a.in[I_SB][((size_t)l * 4 + h) * 128 + t]; const size_t row = (size_t)(r0 + t);
        u32x2 uwv[8];
#pragma unroll
        for (int n = 0; n < 8; ++n) uwv[n] = *(const u32x2*)(Z + row * DIN + ZUC + h * 128 + n * 16 + 4 * fq);
        __builtin_amdgcn_sched_barrier(0);
#pragma unroll
        for (int n = 0; n < 8; ++n) { const int d0 = n * 16 + 4 * fq; const u32x2 uw = uwv[n];
            const float u0 = gelu_t(bflo(uw.x)), u1 = gelu_t(bfhi(uw.x)), u2 = gelu_t(bflo(uw.y)), u3 = gelu_t(bfhi(uw.y));
            u32x2 o; o.x = pk2(u0 * (acc[n][0] + bs), u1 * (acc[n][1] + bs)); o.y = pk2(u2 * (acc[n][2] + bs), u3 * (acc[n][3] + bs));
            *(u32x2*)(MIX + row * DM + MYC + h * 128 + d0) = o; }
    } else {
        const int is = item - 256;
#pragma unroll 1
        for (int q = 0; q < 2; ++q) {
            const int b = is * 16 + wid * 2 + q; const size_t row = (size_t)(MPROMPT + b); const int cc = lane * 8, h = lane >> 4;
            float v[8]; unpack8(*(const u32x4*)(Z + row * DIN + ZVC + cc), v);
            float s = 0.f;
#pragma unroll
            for (int e = 0; e < 8; ++e) { v[e] = gelu_t(v[e]); s += v[e]; }
            const float mean = wave_sum(s) * (1.0f / WC); float qq = 0.f;
#pragma unroll
            for (int e = 0; e < 8; ++e) { v[e] -= mean; qq += v[e] * v[e]; }
            const float rstd = 1.0f / sqrtf(wave_sum(qq) * (1.0f / WC) + EPS);
            const f32x4 g0 = *(const f32x4*)(lg + cc), g1 = *(const f32x4*)(lg + cc + 4), b0 = *(const f32x4*)(lb + cc), b1 = *(const f32x4*)(lb + cc + 4);
            float uu[8]; unpack8(*(const u32x4*)(Z + row * DIN + ZUC + cc), uu);
            const float w00 = a.in[I_SW][((size_t)l * 4 + h) * 16384], bs = a.in[I_SB][((size_t)l * 4 + h) * 128];
            float yv[8];
#pragma unroll
            for (int e = 0; e < 8; ++e) { const float gg = e < 4 ? g0[e & 3] : g1[e & 3], bv = e < 4 ? b0[e & 3] : b1[e & 3]; v[e] = v[e] * rstd * gg + bv; yv[e] = gelu_t(uu[e]) * (w00 * v[e] + bs); }
            float* vo = a.out + O_VS + ((size_t)l * NS + b) * WC + cc;
            *(f32x4*)vo = (f32x4){v[0], v[1], v[2], v[3]}; *(f32x4*)(vo + 4) = (f32x4){v[4], v[5], v[6], v[7]};
            *(u32x4*)(MIX + row * DM + MYC + cc) = pack8(yv);
        }
    }
    __syncthreads();
}

constexpr int SK_AB = 128 * 72 * 2, SK_BB = 64 * 72 * 2, SK_STAGE = SK_AB + SK_BB;
template <int ACT  , int NT  >
__device__ __forceinline__ void skinny_gemm(LAS unsigned char* lds, const bf16_t* __restrict__ As, const bf16_t* __restrict__ Bt, int K, int N, int KSPLIT, bf16_t* obf, const float* base, float* of32, float* rss, int bid, int G) {
    const int tid = opaque_tid(), lane = tid & 63, wid = __builtin_amdgcn_readfirstlane(tid >> 6), fr = lane & 15, fq = lane >> 4;
    const int ncol = N / (16 * NT), nitems = ncol * KSPLIT, klen = K / KSPLIT, S = klen >> 6;
    const int lrow = tid >> 3, lkc = (tid & 7) * 8;
    for (int it = bid; it < nitems; it += G) {
        const int ct = it % ncol, ks = it / ncol, n0 = ct * (16 * NT), k0 = ks * klen; const bool bl = lrow < 16 * NT;
        const bf16_t* ag0 = As + (size_t)lrow * K + k0 + lkc;
        const bf16_t* ag1 = ag0 + (size_t)64 * K;
        const bf16_t* bg = Bt + (size_t)(n0 + (bl ? lrow : 0)) * K + k0 + lkc;
        u32x4 ra0[4], ra1[4], rb[4];
#pragma unroll
        for (int j = 0; j < 4; ++j) { ra0[j] = *(const u32x4*)(ag0 + j * 64); ra1[j] = *(const u32x4*)(ag1 + j * 64); rb[j] = *(const u32x4*)(bg + j * 64); }
        f32x4 acc[NT];
#pragma unroll
        for (int n = 0; n < NT; ++n) acc[n] = (f32x4){0.f, 0.f, 0.f, 0.f};
        for (int s0 = 0; s0 < S; s0 += 4) {
#pragma unroll
            for (int j = 0; j < 4; ++j) {
                LAS unsigned char* buf = lds + (j & 1) * SK_STAGE;
                LAS bf16_t* At = (LAS bf16_t*)buf; LAS bf16_t* Bs = (LAS bf16_t*)(buf + SK_AB);
                *(LAS u32x4*)(At + lrow * 72 + lkc) = ra0[j]; *(LAS u32x4*)(At + (64 + lrow) * 72 + lkc) = ra1[j]; if (bl) *(LAS u32x4*)(Bs + lrow * 72 + lkc) = rb[j];
                if (s0 + j + 4 < S) { const int ko = (s0 + j + 4) * 64; ra0[j] = *(const u32x4*)(ag0 + ko); ra1[j] = *(const u32x4*)(ag1 + ko); rb[j] = *(const u32x4*)(bg + ko); }
                __syncthreads();
#pragma unroll
                for (int kk = 0; kk < 2; ++kk) {
                    const bf16x8 af = *(const LAS bf16x8*)(At + (16 * wid + fr) * 72 + kk * 32 + fq * 8);
#pragma unroll
                    for (int n = 0; n < NT; ++n) { const bf16x8 bf = *(const LAS bf16x8*)(Bs + (n * 16 + fr) * 72 + kk * 32 + fq * 8);
                        acc[n] = __builtin_amdgcn_mfma_f32_16x16x32_bf16(bf, af, acc[n], 0, 0, 0); }
                }
            }
        }
        __syncthreads();
        const int r = 16 * wid + fr;
        f32x4 bsv[NT]; float rstd = 1.f, ss = 0.f;
        if (ACT == 3) {
#pragma unroll
            for (int n = 0; n < NT; ++n) bsv[n] = *(const f32x4*)(base + (size_t)r * N + n0 + n * 16 + 4 * fq);
            __builtin_amdgcn_sched_barrier(0); }
        if (ACT == 0 || ACT == 2) rstd = __builtin_amdgcn_rsqf(rss[r] * (1.0f / DM) + EPS);
#pragma unroll
        for (int n = 0; n < NT; ++n) {
            const int c = n0 + n * 16 + 4 * fq; f32x4 v = acc[n];
            if (ACT == 3) { v = v + bsv[n]; *(f32x4*)(of32 + (size_t)r * N + c) = v;
                u32x2 w; w.x = pk2(v[0], v[1]); w.y = pk2(v[2], v[3]); *(u32x2*)(obf + (size_t)r * N + c) = w; ss += (v[0] * v[0] + v[1] * v[1]) + (v[2] * v[2] + v[3] * v[3]); }
            else if (ACT == 4) { *(f32x4*)(of32 + ((size_t)ks * 128 + r) * N + c) = v; }
            else {
                v = v * rstd;
                if (ACT == 2) {
#pragma unroll
                    for (int e = 0; e < 4; ++e) { const float t = fmaxf(v[e], 0.f); v[e] = t * t; } }
                u32x2 w; w.x = pk2(v[0], v[1]); w.y = pk2(v[2], v[3]); *(u32x2*)(obf + (size_t)r * N + c) = w; }
        }
        if (ACT == 3) { ss += __shfl_xor(ss, 16); ss += __shfl_xor(ss, 32); if (fq == 0) atomicAdd(rss + r, ss); }
    }
}

__device__ __forceinline__ void sample_fold(const Args& a, int bid, float* rss, unsigned* flag) {
    const int tid = opaque_tid(), lane = tid & 63;
    if (bid < NS && tid < 64) {
        float* xr = (float*)(a.ws + WS_X) + (size_t)(MPROMPT + bid) * DM; bf16_t* hb = (bf16_t*)(a.ws + WS_HN) + (size_t)(MPROMPT + bid) * DM; const float* part = (const float*)(a.ws + WS_PART);
        f32x4 v[8]; float ss = 0.f;
#pragma unroll
        for (int j = 0; j < 8; ++j) v[j] = ((const f32x4*)xr)[lane + 64 * j];
#pragma unroll 1
        for (int ks = 0; ks < 8; ks += 2) { const f32x4* pr = (const f32x4*)(part + ((size_t)ks * NS + bid) * DM); const f32x4* pr2 = pr + (size_t)NS * DM / 4;
            f32x4 t0[8], t1[8];
#pragma unroll
            for (int j = 0; j < 8; ++j) { t0[j] = pr[lane + 64 * j]; t1[j] = pr2[lane + 64 * j]; }
            __builtin_amdgcn_sched_barrier(0);
#pragma unroll
            for (int j = 0; j < 8; ++j) v[j] += t0[j] + t1[j]; }
#pragma unroll
        for (int j = 0; j < 8; ++j) { ((f32x4*)xr)[lane + 64 * j] = v[j]; u32x2 w; w.x = pk2(v[j][0], v[j][1]); w.y = pk2(v[j][2], v[j][3]); ((u32x2*)hb)[lane + 64 * j] = w;
            ss += (v[j][0] * v[j][0] + v[j][1] * v[j][1]) + (v[j][2] * v[j][2] + v[j][3] * v[j][3]); }
        ss = wave_sum(ss);
        if (lane == 0) rss[bid] = ss;
        __threadfence();
        if (lane == 0) __hip_atomic_fetch_add(flag, 1u, __ATOMIC_RELAXED, __HIP_MEMORY_SCOPE_AGENT);
    }
}

#define XB_TMO      128
#define XB_XCNT(j)  (256  + 64 * (j))
#define XB_XSUB(j)  (1280 + 64 * (j))
#define XB_XGEN(j)  (2304 + 64 * (j))
#define XB_TOP      3328
#define XB_TOPGEN   3392
#define XCD_BAR_WORDS 3456
#define XB_SPIN_CAP (1u << 18)

__device__ __forceinline__ unsigned xb_ld(unsigned* p)              { return __hip_atomic_load(p, __ATOMIC_RELAXED, __HIP_MEMORY_SCOPE_AGENT); }
__device__ __forceinline__ unsigned xb_add(unsigned* p, unsigned v) { return __hip_atomic_fetch_add(p, v, __ATOMIC_RELAXED, __HIP_MEMORY_SCOPE_AGENT); }
__device__ __forceinline__ unsigned xb_xcc_id() { return (unsigned)__builtin_amdgcn_s_getreg((3 << 11) | 20) & 0xFu; }
#define XB_SPIN(cond, bar) do { unsigned _sp = 0; while (cond) { __builtin_amdgcn_s_sleep(1); \
    if ((++_sp & 255u) == 0u) { if (xb_ld(&(bar)[XB_TMO])) break; if (_sp > XB_SPIN_CAP) { atomicAdd(&(bar)[XB_TMO], 1u); break; } } } } while (0)

struct XcdBarrier {
    unsigned* bar; unsigned x;
    volatile LAS unsigned* st;
};

__device__ __forceinline__ XcdBarrier xcd_barrier_post(unsigned* bar, volatile LAS unsigned* st) {
    XcdBarrier b; b.bar = bar; b.x = xb_xcc_id(); b.st = st;
    if (threadIdx.x == 0) (void)xb_add(&bar[XB_XCNT(b.x)], 1u);
    return b;
}
__device__ __forceinline__ void xcd_barrier_complete(unsigned* bar, unsigned x, unsigned& nloc, unsigned& nx) {
    const unsigned G = gridDim.x * gridDim.y * gridDim.z;
    unsigned sum, cnt, mine, sp = 0u;
    for (;;) {
        sum = 0u; cnt = 0u; mine = 0u;
#pragma unroll
        for (unsigned j = 0; j < 16; ++j) { const unsigned c = xb_ld(&bar[XB_XCNT(j)]); sum += c; cnt += (c > 0u) ? 1u : 0u; mine = (j == x) ? c : mine; }
        if (sum == G) break;
        __builtin_amdgcn_s_sleep(1);
        if ((++sp & 255u) == 0u) { if (xb_ld(&bar[XB_TMO])) break; if (sp > XB_SPIN_CAP) { atomicAdd(&bar[XB_TMO], 1u); break; } }
    }
    nloc = mine > 0u ? mine : 1u; nx = cnt > 0u ? cnt : 1u;
}

__device__ __forceinline__ void xcd_barrier(const XcdBarrier& b) {
    asm volatile("s_waitcnt vmcnt(0)" ::: "memory");
    __syncthreads();
    if (threadIdx.x == 0) {
        unsigned* bar = b.bar;
        __builtin_amdgcn_s_waitcnt(0);
        unsigned nloc = b.st[0], nx = b.st[1];
        if (nloc == 0u) { xcd_barrier_complete(bar, b.x, nloc, nx); b.st[0] = nloc; b.st[1] = nx; }
        const unsigned old = xb_add(&bar[XB_XSUB(b.x)], 1u);
        const unsigned gen = old / nloc;
        if (old + 1u == (gen + 1u) * nloc) {
            __builtin_amdgcn_fence(__ATOMIC_RELEASE, "agent");
            asm volatile("s_waitcnt vmcnt(0)" ::: "memory");
            const unsigned og = xb_add(&bar[XB_TOP], 1u);
            const unsigned tg = og / nx;
            if (og + 1u == (tg + 1u) * nx) xb_add(&bar[XB_TOPGEN], 1u);
            else XB_SPIN(xb_ld(&bar[XB_TOPGEN]) == tg, bar);
            __builtin_amdgcn_fence(__ATOMIC_ACQUIRE, "agent");
            xb_add(&bar[XB_XGEN(b.x)], 1u);
            asm volatile("s_waitcnt vmcnt(0)" ::: "memory");
        } else {
            XB_SPIN(xb_ld(&bar[XB_XGEN(b.x)]) == gen, bar);
            __builtin_amdgcn_fence(__ATOMIC_ACQUIRE, "agent");
            asm volatile("s_waitcnt vmcnt(0)" ::: "memory");
        }
    }
    __syncthreads();
}

constexpr int N_PHASES = 2 + 6 * DEPTH;
#ifndef REP_MIX
#define REP_MIX 1
#endif
#ifndef FOLD_FLAG
#define FOLD_FLAG 1
#endif
#ifndef WGM_G1
#define WGM_G1 4
#endif
#ifndef WGM_G2
#define WGM_G2 4
#endif
#ifndef WGM_G3
#define WGM_G3 4
#endif
#ifndef WGM_G4
#define WGM_G4 4
#endif
#ifndef REP_A
#define REP_A 1
#endif
#ifndef REP_B
#define REP_B 1
#endif
#ifndef REP_C
#define REP_C 1
#endif
__global__ void __launch_bounds__(512, 2) mega_fwd(Args a) {
    extern __shared__ __attribute__((aligned(16))) unsigned char lds_raw[];
    LAS unsigned char* lds = (LAS unsigned char*)lds_raw;
    cg::grid_group grid = cg::this_grid();
    const int G = gridDim.x, bid = blockIdx.x, NGW = G * 8;
    const int lo = a.ph_lo, hi = a.ph_hi;
    if (lo < 0) grid.sync();
    volatile LAS unsigned* bst = (volatile LAS unsigned*)(lds + LDS_BYTES - 64);
    if (threadIdx.x < 2) bst[threadIdx.x] = 0u;
    __syncthreads();
    XcdBarrier bar = xcd_barrier_post((unsigned*)a.ws, bst);
#define IN(k) (lo <= (k) && (k) < hi)
#define SEAM(k) do { if (IN(k) && IN((k) + 1)) xcd_barrier(bar); } while (0)
    bf16_t* HN = (bf16_t*)(a.ws + WS_HN); bf16_t* Zb = (bf16_t*)(a.ws + WS_Z); bf16_t* MIXb = (bf16_t*)(a.ws + WS_MIX); bf16_t* FFb = (bf16_t*)(a.ws + WS_FF);
    float* X = (float*)(a.ws + WS_X); float* RS = (float*)(a.ws + WS_RS);
    float* Xs = X + (size_t)MPROMPT * DM; bf16_t* HNs = HN + (size_t)MPROMPT * DM;

    if (IN(0)) {
        for (int i = bid * 512 + (int)threadIdx.x; i < 3 * MV; i += G * 512) RS[MV + i] = 0.f;
        phase_prep(a, lds, bid, NGW); phase_rms(a.in[I_XP], a.in[I_XS], a.in[I_NMIX], HN, nullptr, bid, NGW, nullptr, nullptr, RS); }
    SEAM(0);
#ifdef REP_SYNC
    for (int rep = 0; rep < REP_SYNC; ++rep) xcd_barrier(bar);
#endif
#pragma unroll 1
    for (int l = 0; l < DEPTH; ++l) {
        const int p = 1 + 6 * l;
        float* rsA = RS + (size_t)(2 * l) * MV; float* rsF = RS + (size_t)(2 * l + 1) * MV; float* rsN = RS + (size_t)(2 * l + 2) * MV;
        if (IN(p)) {
            const bf16_t* Wt = (const bf16_t*)(a.ws + WS_WIN) + (size_t)l * DM * DIN;
            pg8::Gemm g{HN, Wt, MPROMPT, DIN, DM}; pg8::StaticOrder S; S.init(MPROMPT, DIN, G, bid, WGM_G1);
            pg8::EpiBf16<0> E{Zb, DIN, rsA, 1.0f / DM, EPS};
            unsigned* sflag = (unsigned*)(a.ws + WS_QCTR) + 64 * (8 + l);
            if (FOLD_FLAG && l > 0) sample_fold(a, bid, rsA + MPROMPT, sflag);
            pg8::gemm_phase<pg8::EpiBf16<0>, pg8::StaticOrder, true, true>(lds, g, S, E);
            if (FOLD_FLAG && l > 0) {
                if (threadIdx.x == 0) { unsigned sp = 0; while (__hip_atomic_load(sflag, __ATOMIC_RELAXED, __HIP_MEMORY_SCOPE_AGENT) < (unsigned)NS && ++sp < (1u << 22)) __builtin_amdgcn_s_sleep(2);
                    __builtin_amdgcn_fence(__ATOMIC_ACQUIRE, "agent"); asm volatile("s_waitcnt vmcnt(0)" ::: "memory"); }
                __syncthreads(); }
            skinny_gemm<0, 1>(lds, HNs, Wt, DM, DIN, 1, Zb + (size_t)MPROMPT * DIN, nullptr, nullptr, rsA + MPROMPT, bid, G);
        }
        SEAM(p);
        if (IN(p + 1)) {
            __syncthreads();
            unsigned* qctr = (unsigned*)(a.ws + WS_QCTR) + 64 * (2 * l);
            volatile LAS unsigned* qslot = (volatile LAS unsigned*)(lds + LDS_BYTES - 32);
            unsigned nxt = 0u;
            if (threadIdx.x == 0) nxt = __hip_atomic_fetch_add(qctr, 1u, __ATOMIC_RELAXED, __HIP_MEMORY_SCOPE_AGENT);
            for (;;) {
                if (threadIdx.x == 0) { qslot[0] = nxt; nxt = __hip_atomic_fetch_add(qctr, 1u, __ATOMIC_RELAXED, __HIP_MEMORY_SCOPE_AGENT); }
                __syncthreads();
                const int it = (int)qslot[0];
                __syncthreads();
                if (it >= 520 + 264 + 288) break;
                if (it < 520) { for (int rep = 0; rep < REP_A; ++rep) mixA_item(a, lds, l, it); }
                else if (it < 784) { for (int rep = 0; rep < REP_C; ++rep) mixC_item(a, lds, l, it - 520); }
                else { for (int rep = 0; rep < REP_B; ++rep) mixB_item(a, lds, l, it - 784); }
            }
        }
        SEAM(p + 1);
        if (IN(p + 2)) {
            for (int rep = 0; rep < REP_MIX; ++rep)
            for (int it = bid; it < 512; it += G) mixA2_item(a, lds, l, it);
        }
        SEAM(p + 2);
        if (IN(p + 3)) {
            const bf16_t* Wt = (const bf16_t*)(a.ws + WS_WOUT) + (size_t)l * DM * DM;
            pg8::Gemm g{MIXb, Wt, MPROMPT, DM, DM}; pg8::StaticOrder S; S.init(MPROMPT, DM, G, bid, WGM_G2);
            pg8::EpiResF32 E{l == 0 ? a.in[I_XP] : X, X, DM, HN, rsF};
            pg8::gemm_phase<pg8::EpiResF32, pg8::StaticOrder, true, true>(lds, g, S, E);
            skinny_gemm<3, 1>(lds, MIXb + (size_t)MPROMPT * DM, Wt, DM, DM, 1, HNs, l == 0 ? a.in[I_XS] : Xs, Xs, rsF + MPROMPT, bid, G);
        }
        SEAM(p + 3);
        if (IN(p + 4)) {
            const bf16_t* Wt = (const bf16_t*)(a.ws + WS_WFF1) + (size_t)l * DM * DFF;
            pg8::Gemm g{HN, Wt, MPROMPT, DFF, DM}; pg8::StaticOrder S; S.init(MPROMPT, DFF, G, bid, WGM_G3);
            pg8::EpiBf16<2> E{FFb, DFF, rsF, 1.0f / DM, EPS};
            pg8::gemm_phase<pg8::EpiBf16<2>, pg8::StaticOrder, true, true>(lds, g, S, E);
            skinny_gemm<2, 2>(lds, HNs, Wt, DM, DFF, 1, FFb + (size_t)MPROMPT * DFF, nullptr, nullptr, rsF + MPROMPT, bid, G);
        }
        SEAM(p + 4);
        if (IN(p + 5)) {
            const bf16_t* Wt = (const bf16_t*)(a.ws + WS_WFF2) + (size_t)l * DM * DFF;
            pg8::Gemm g{FFb, Wt, MPROMPT, DM, DFF}; pg8::StaticOrder S; S.init(MPROMPT, DM, G, bid, WGM_G4);
            const bool last = (l + 1 == DEPTH);
            pg8::EpiResF32 E{X, X, DM, last ? nullptr : HN, last ? nullptr : rsN};
            pg8::gemm_phase<pg8::EpiResF32, pg8::StaticOrder, true, true>(lds, g, S, E);
            if (FOLD_FLAG || last) skinny_gemm<4, 4>(lds, FFb + (size_t)MPROMPT * DFF, Wt, DFF, DM, 8, nullptr, nullptr, (float*)(a.ws + WS_PART), nullptr, bid, G);
            else skinny_gemm<3, 2>(lds, FFb + (size_t)MPROMPT * DFF, Wt, DFF, DM, 1, HNs, Xs, Xs, rsN + MPROMPT, bid, G);
        }
        SEAM(p + 5);
    }
    if (IN(1 + 6 * DEPTH)) phase_rms(X, Xs, a.in[I_NFIN], nullptr, a.out + O_YP, bid, NGW, (const float*)(a.ws + WS_PART), Xs);
#undef IN
#undef SEAM
}

#ifndef MK_PER_PHASE
#define MK_PER_PHASE 0
#endif
extern "C" void kernel_launch(void* const* d_in, const int* in_sizes, int n_in, void* d_out, int out_size, void* d_ws, size_t ws_size, hipStream_t stream) {
    static int grid = 0;
    if (grid == 0) {
        if (n_in != N_INPUTS || ws_size < WS_END) { fprintf(stderr, "kernel_launch: unexpected n_in %d / ws %zu\n", n_in, ws_size); grid = -1; return; }
        int dev = 0, cus = 0, per_cu = 0;
        (void)hipGetDevice(&dev); (void)hipDeviceGetAttribute(&cus, hipDeviceAttributeMultiprocessorCount, dev);
        if (hipFuncSetAttribute((const void*)mega_fwd, hipFuncAttributeMaxDynamicSharedMemorySize, LDS_BYTES) != hipSuccess) { fprintf(stderr, "kernel_launch: hipFuncSetAttribute failed\n"); grid = -1; return; }
        if (hipOccupancyMaxActiveBlocksPerMultiprocessor(&per_cu, (const void*)mega_fwd, 512, LDS_BYTES) != hipSuccess || per_cu < 1) per_cu = 1;
        (void)hipGetLastError();
        if (cus <= 0) cus = 256;
        grid = cus * per_cu;
    }
    if (grid < 0) return;
    if (hipMemsetAsync(d_ws, 0, 32768, stream) != hipSuccess) { fprintf(stderr, "kernel_launch: memset failed\n"); return; }
    Args a{};
    for (int i = 0; i < N_INPUTS; ++i) a.in[i] = (const float*)d_in[i];
    a.out = (float*)d_out; a.ws = (unsigned char*)d_ws;
#if MK_PER_PHASE
    for (int p = 0; p < N_PHASES; ++p) { a.ph_lo = p; a.ph_hi = p + 1; hipLaunchKernelGGL(mega_fwd, dim3(grid), dim3(512), LDS_BYTES, stream, a); }
#else
    a.ph_lo = 0; a.ph_hi = N_PHASES;
    void* kargs[] = {&a};
    hipError_t e = hipLaunchCooperativeKernel((const void*)mega_fwd, dim3(grid), dim3(512), kargs, LDS_BYTES, stream);
    if (e != hipSuccess) fprintf(stderr, "cooperative launch failed: %s (grid %d)\n", hipGetErrorString(e), grid);
#endif
}
```

```cpp
#include <hip/hip_runtime.h>
#include <hip/hip_cooperative_groups.h>
#include <cstdio>
#include <cstdint>
namespace cg = cooperative_groups;

namespace pg8 {
#define PG8_LAS __attribute__((address_space(3)))
typedef unsigned short bf16_t;
typedef short bf16x8 __attribute__((ext_vector_type(8)));
typedef float f32x4 __attribute__((ext_vector_type(4)));
typedef unsigned u32x4 __attribute__((ext_vector_type(4)));
constexpr int BM = 256, BK = 64, HALF = 128, HTB = HALF * BK * 2  , STAGE_BYTES = 8 * HTB, NXCD = 8, WGM = 8;

__host__ __device__ __forceinline__ int lds_byte(int r, int c) { const int st = (r >> 4) * 2 + (c >> 5), rr = r & 15, cc = c & 31, ob = rr * 64 + cc * 2; return st * 1024 + (ob ^ (((ob >> 9) & 1) << 5)); }
__host__ __device__ __forceinline__ void stage_rc(int b, int& R, int& C) { const int st = b / 1024, sb = b % 1024, swz = sb ^ (((sb >> 9) & 1) << 5); R = (st >> 1) * 16 + swz / 64; C = (st & 1) * 32 + (swz % 64) / 2; }
__host__ __device__ __forceinline__ int perm32(int rho) { const int n = rho >> 4, i = rho & 15; return 8 * (i >> 2) + 4 * n + (i & 3); }

struct Unit { int pm, pn; };
struct Gemm { const bf16_t* A; const bf16_t* Bt; int M, N, K; };

struct StaticOrder {
    int nM, nN, nwg, G, c, wgm;
    __host__ __device__ void init(int M, int N, int G_, int c_, int wgm_ = WGM) { nM = M / BM; nN = N / BM; nwg = nM * nN; G = G_; c = c_; wgm = wgm_; }
    __host__ __device__ bool next(int i, Unit& u) const {
        const long L = (long)i * G + c; if (L >= nwg) return false;
        int wgid = (int)L; { const int q = nwg / NXCD, r = nwg % NXCD, xcd = wgid % NXCD, off = wgid / NXCD; wgid = (xcd < r ? xcd * (q + 1) : r * (q + 1) + (xcd - r) * q) + off; }
        const int nig = wgm * nN, gid = wgid / nig, fm = gid * wgm, gsz = (nM - fm) < wgm ? (nM - fm) : wgm;
        u.pm = fm + ((wgid % nig) % gsz); u.pn = (wgid % nig) / gsz; return true;
    }
    __device__ __forceinline__ void a_ready(const Unit&) const {}
    __device__ __forceinline__ void done(const Unit&) const {}
};

__device__ __forceinline__ unsigned cvt_pk_bf16(float lo, float hi) { unsigned r; asm volatile("v_cvt_pk_bf16_f32 %0, %1, %2" : "=v"(r) : "v"(lo), "v"(hi)); return r; }

template <int ACT  > struct EpiBf16 {
    static constexpr bool PERM = true, AFTER_DRAIN = false;
    bf16_t* O; int ldc; const float* rss; float inv_k, eps;
    __device__ __forceinline__ void operator()(const f32x4 (&acc)[2][2][4][2], const Unit& u, int wr, int wc, int fr, int fq) const {
        const int row0 = u.pm * BM + wr * 64 + fr; const int col0 = u.pn * BM + wc * 32 + 8 * fq;
        float rs[2][4];
#pragma unroll
        for (int ai = 0; ai < 2; ++ai)
#pragma unroll
            for (int m = 0; m < 4; ++m) rs[ai][m] = rss[row0 + ai * HALF + m * 16];
        __builtin_amdgcn_sched_barrier(0);
#pragma unroll
        for (int ai = 0; ai < 2; ++ai)
#pragma unroll
            for (int m = 0; m < 4; ++m) { bf16_t* rowp = O + (size_t)(row0 + ai * HALF + m * 16) * ldc + col0;
                const float rstd = __builtin_amdgcn_rsqf(rs[ai][m] * inv_k + eps);
#pragma unroll
                for (int bj = 0; bj < 2; ++bj) { f32x4 v0 = acc[ai][bj][m][0] * rstd, v1 = acc[ai][bj][m][1] * rstd;
                    if (ACT == 2) {
#pragma unroll
                        for (int e = 0; e < 4; ++e) { float a = fmaxf(v0[e], 0.f), b = fmaxf(v1[e], 0.f); v0[e] = a * a; v1[e] = b * b; } }
                    u32x4 w; w.x = cvt_pk_bf16(v0[0], v0[1]); w.y = cvt_pk_bf16(v0[2], v0[3]); w.z = cvt_pk_bf16(v1[0], v1[1]); w.w = cvt_pk_bf16(v1[2], v1[3]);
                    *(u32x4*)(rowp + bj * HALF) = w; } }
    }
};
typedef unsigned u32x2_t __attribute__((ext_vector_type(2)));
struct EpiResF32 {
    static constexpr bool PERM = false, AFTER_DRAIN = false;
    const float* base; float* out; int ldc; bf16_t* xb; float* rss;
    __device__ __forceinline__ void operator()(const f32x4 (&acc)[2][2][4][2], const Unit& u, int wr, int wc, int fr, int fq) const {
        const int col0 = u.pn * BM + wc * 32 + 4 * fq;
#pragma unroll
        for (int ai = 0; ai < 2; ++ai) {
            f32x4 bs[4][2][2];
#pragma unroll
            for (int m = 0; m < 4; ++m) { const float* b = base + (size_t)(u.pm * BM + ai * HALF + wr * 64 + m * 16 + fr) * ldc + col0;
#pragma unroll
                for (int bj = 0; bj < 2; ++bj)
#pragma unroll
                    for (int n = 0; n < 2; ++n) bs[m][bj][n] = *(const f32x4*)(b + bj * HALF + n * 16); }
            __builtin_amdgcn_sched_barrier(0);
#pragma unroll
            for (int m = 0; m < 4; ++m) { const int r = u.pm * BM + ai * HALF + wr * 64 + m * 16 + fr; float* o = out + (size_t)r * ldc + col0; float ss = 0.f;
#pragma unroll
                for (int bj = 0; bj < 2; ++bj)
#pragma unroll
                    for (int n = 0; n < 2; ++n) { const f32x4 v = bs[m][bj][n] + acc[ai][bj][m][n]; *(f32x4*)(o + bj * HALF + n * 16) = v;
                        if (xb) { u32x2_t w; w.x = cvt_pk_bf16(v[0], v[1]); w.y = cvt_pk_bf16(v[2], v[3]); *(u32x2_t*)(xb + (size_t)r * ldc + col0 + bj * HALF + n * 16) = w; ss += (v[0] * v[0] + v[1] * v[1]) + (v[2] * v[2] + v[3] * v[3]); } }
                if (xb) { ss += __shfl_xor(ss, 16); ss += __shfl_xor(ss, 32); if (fq == 0) atomicAdd(rss + r, ss); } }
            __builtin_amdgcn_sched_barrier(0);
        }
    }
};

template <class Epi, class Sched, bool ALIGN_EPI = false, bool SP2 = false>
__device__ __forceinline__ void gemm_phase(PG8_LAS unsigned char* lds, const Gemm g, const Sched& S, const Epi& E) {
    int tid_ = threadIdx.x; asm volatile("" : "+v"(tid_));
    const int tid = tid_, wid = __builtin_amdgcn_readfirstlane(tid >> 6), lane = tid & 63, wr = wid >> 2, wc = wid & 3, fr = lane & 15, fq = lane >> 4;
    const int K = g.K, nt = K / BK;
    unsigned voffA[2], voffB[2];
#pragma unroll
    for (int i = 0; i < 2; ++i) { int R, C; stage_rc(tid * 16 + i * 8192, R, C); const int Rb = Epi::PERM ? ((R & ~31) + perm32(R & 31)) : R;
        voffA[i] = (unsigned)(R * K + C) * 2u; voffB[i] = (unsigned)(Rb * K + C) * 2u; }
    const size_t kstep = (size_t)(BK * 2);
    const size_t hstep = (size_t)HALF * K * 2;
    const size_t tstep = 2 * hstep;
    const unsigned ldsw = (unsigned)wid * 1024u;
    const int aoff = lds_byte(wr * 64 + fr, fq * 8), boff = lds_byte(wc * 32 + fr, fq * 8);
#define PG8_SA(b, h) (((b) * 2 + (h)) * HTB)
#define PG8_SB(b, h) ((4 + (b) * 2 + (h)) * HTB)
#define PG8_STAGE(bufoff, gbase, voff) do { _Pragma("unroll") for (int _i = 0; _i < 2; ++_i) \
        __builtin_amdgcn_global_load_lds((const unsigned*)((const char*)(gbase) + (voff)[_i]), (PG8_LAS unsigned*)(lds + (bufoff) + ldsw + _i * 8192), 16, 0, 0); } while (0)
#define PG8_LDA(dst, b, h) do { _Pragma("unroll") for (int m = 0; m < 4; ++m) _Pragma("unroll") for (int k = 0; k < 2; ++k) dst[m][k] = *(const PG8_LAS bf16x8*)(lds + PG8_SA(b, h) + aoff + m * 2048 + k * 1024); } while (0)
#define PG8_LDB(dst, b, h) do { _Pragma("unroll") for (int n = 0; n < 2; ++n) _Pragma("unroll") for (int k = 0; k < 2; ++k) dst[n][k] = *(const PG8_LAS bf16x8*)(lds + PG8_SB(b, h) + boff + n * 2048 + k * 1024); } while (0)
#define PG8_MMA(ai, bj, At, Bt) do { __builtin_amdgcn_s_setprio(1); _Pragma("unroll") for (int m = 0; m < 4; ++m) _Pragma("unroll") for (int n = 0; n < 2; ++n) _Pragma("unroll") for (int k = 0; k < 2; ++k) \
        acc[ai][bj][m][n] = __builtin_amdgcn_mfma_f32_16x16x32_bf16(Bt[n][k], At[m][k], acc[ai][bj][m][n], 0, 0, 0); __builtin_amdgcn_s_setprio(0); } while (0)
#define PG8_WAIT_V(n) asm volatile("s_waitcnt vmcnt(" #n ")" ::: "memory")
#define PG8_WAIT_L(n) asm volatile("s_waitcnt lgkmcnt(" #n ")" ::: "memory")
#define PG8_BAR __builtin_amdgcn_s_barrier()
#define PG8_SCHED __builtin_amdgcn_sched_barrier(0)
    Unit cur, nxt; int ui = 0;
    if (!S.next(0, cur)) return;
    f32x4 acc[2][2][4][2];
#pragma unroll
    for (int a = 0; a < 2; ++a)
#pragma unroll
        for (int b = 0; b < 2; ++b)
#pragma unroll
            for (int m = 0; m < 4; ++m)
#pragma unroll
                for (int n = 0; n < 2; ++n) acc[a][b][m][n] = (f32x4){0.f, 0.f, 0.f, 0.f};
    bf16x8 At[4][2], B0[2][2], B1[2][2];
    const char* cA = (const char*)g.A + (size_t)cur.pm * tstep; const char* cB = (const char*)g.Bt + (size_t)cur.pn * tstep;
    S.a_ready(cur);
    if constexpr (SP2) {
        PG8_STAGE(PG8_SB(0, 0), cB, voffB); PG8_STAGE(PG8_SB(0, 1), cB + hstep, voffB); PG8_STAGE(PG8_SA(0, 0), cA, voffA); PG8_STAGE(PG8_SA(0, 1), cA + hstep, voffA);
        if (wr == 1) PG8_BAR;
        PG8_WAIT_V(2); PG8_BAR;
        PG8_STAGE(PG8_SB(1, 0), cB + kstep, voffB); PG8_STAGE(PG8_SA(1, 0), cA + kstep, voffA); PG8_STAGE(PG8_SB(1, 1), cB + hstep + kstep, voffB);
        PG8_WAIT_V(6); PG8_BAR;
    } else {
        PG8_STAGE(PG8_SB(0, 0), cB, voffB); PG8_STAGE(PG8_SA(0, 0), cA, voffA); PG8_STAGE(PG8_SB(0, 1), cB + hstep, voffB); PG8_STAGE(PG8_SA(0, 1), cA + hstep, voffA);
        if (wr == 1) PG8_BAR;
        PG8_WAIT_V(4); PG8_BAR;
        PG8_STAGE(PG8_SB(1, 0), cB + kstep, voffB); PG8_STAGE(PG8_SA(1, 0), cA + kstep, voffA); PG8_STAGE(PG8_SB(1, 1), cB + hstep + kstep, voffB);
        PG8_WAIT_V(6); PG8_BAR;
    }
    for (;;) {
        const bool has_next = S.next(ui + 1, nxt);
        const char* nA = has_next ? (const char*)g.A + (size_t)nxt.pm * tstep : cA; const char* nB = has_next ? (const char*)g.Bt + (size_t)nxt.pn * tstep : cB;
        for (int t = 0; t < nt; t += 2) {
            const bool last = (t == nt - 2);
            const char* a1 = cA + (size_t)(t + 1) * kstep;
            const char* a2 = last ? nA : cA + (size_t)(t + 2) * kstep; const char* b2 = last ? nB : cB + (size_t)(t + 2) * kstep;
            const char* a3 = a2 + kstep; const char* b3 = b2 + kstep;
            if (last && has_next) S.a_ready(nxt);
            if constexpr (SP2) {
            PG8_LDB(B0, 0, 0); PG8_LDB(B1, 0, 1); PG8_SCHED; PG8_LDA(At, 0, 0); PG8_STAGE(PG8_SA(1, 1), a1 + hstep, voffA);
            PG8_WAIT_V(8); PG8_WAIT_L(0); PG8_BAR; PG8_MMA(0, 0, At, B0); PG8_MMA(0, 1, At, B1); PG8_BAR; PG8_SCHED;
            PG8_LDA(At, 0, 1); PG8_STAGE(PG8_SB(0, 0), b2, voffB); PG8_STAGE(PG8_SB(0, 1), b2 + hstep, voffB); PG8_STAGE(PG8_SA(0, 0), a2, voffA);
            PG8_WAIT_V(8); PG8_WAIT_L(0); PG8_BAR; PG8_MMA(1, 0, At, B0); PG8_MMA(1, 1, At, B1); PG8_BAR; PG8_SCHED;
            PG8_LDB(B0, 1, 0); PG8_LDB(B1, 1, 1); PG8_SCHED; PG8_LDA(At, 1, 0); PG8_STAGE(PG8_SA(0, 1), a2 + hstep, voffA);
            PG8_WAIT_V(8); PG8_WAIT_L(0); PG8_BAR; PG8_MMA(0, 0, At, B0); PG8_MMA(0, 1, At, B1); PG8_BAR; PG8_SCHED;
            PG8_LDA(At, 1, 1); PG8_STAGE(PG8_SB(1, 0), b3, voffB); PG8_STAGE(PG8_SB(1, 1), b3 + hstep, voffB); PG8_STAGE(PG8_SA(1, 0), a3, voffA);
            PG8_WAIT_V(8); PG8_WAIT_L(0); PG8_BAR; PG8_MMA(1, 0, At, B0); PG8_MMA(1, 1, At, B1); PG8_BAR; PG8_SCHED;
            } else {
            PG8_LDB(B0, 0, 0); PG8_SCHED; PG8_LDA(At, 0, 0); PG8_STAGE(PG8_SA(1, 1), a1 + hstep, voffA);
            PG8_WAIT_L(8); PG8_BAR; PG8_WAIT_L(0); PG8_MMA(0, 0, At, B0); PG8_BAR; PG8_SCHED;
            PG8_LDB(B1, 0, 1); PG8_STAGE(PG8_SB(0, 0), b2, voffB);
            PG8_BAR; PG8_WAIT_L(0); PG8_MMA(0, 1, At, B1); PG8_BAR;
            PG8_LDA(At, 0, 1); PG8_STAGE(PG8_SA(0, 0), a2, voffA);
            PG8_BAR; PG8_WAIT_L(0); PG8_MMA(1, 0, At, B0); PG8_BAR; PG8_SCHED;
            PG8_STAGE(PG8_SB(0, 1), b2 + hstep, voffB);
            PG8_WAIT_V(6); PG8_BAR; PG8_MMA(1, 1, At, B1); PG8_BAR;
            PG8_LDB(B0, 1, 0); PG8_SCHED; PG8_LDA(At, 1, 0); PG8_STAGE(PG8_SA(0, 1), a2 + hstep, voffA);
            PG8_WAIT_L(8); PG8_BAR; PG8_WAIT_L(0); PG8_MMA(0, 0, At, B0); PG8_BAR; PG8_SCHED;
            PG8_LDB(B1, 1, 1); PG8_STAGE(PG8_SB(1, 0), b3, voffB);
            PG8_BAR; PG8_WAIT_L(0); PG8_MMA(0, 1, At, B1); PG8_BAR;
            PG8_LDA(At, 1, 1); PG8_STAGE(PG8_SA(1, 0), a3, voffA);
            PG8_BAR; PG8_WAIT_L(0); PG8_MMA(1, 0, At, B0); PG8_BAR; PG8_SCHED;
            PG8_STAGE(PG8_SB(1, 1), b3 + hstep, voffB);
            PG8_WAIT_V(6); PG8_BAR; PG8_MMA(1, 1, At, B1); PG8_BAR;
            }
        }
        if constexpr (ALIGN_EPI) { if (wr == 0) PG8_BAR; }
        if constexpr (!Epi::AFTER_DRAIN) { E(acc, cur, wr, wc, fr, fq); S.done(cur); }
        if (!has_next) break;
#pragma unroll
        for (int a = 0; a < 2; ++a)
#pragma unroll
            for (int b = 0; b < 2; ++b)
#pragma unroll
                for (int m = 0; m < 4; ++m)
#pragma unroll
                    for (int n = 0; n < 2; ++n) acc[a][b][m][n] = (f32x4){0.f, 0.f, 0.f, 0.f};
        cur = nxt; cA = nA; cB = nB; ++ui;
        if constexpr (ALIGN_EPI) { if (wr == 1) PG8_BAR; }
    }
    PG8_WAIT_V(0);
    if constexpr (!ALIGN_EPI) { if (wr == 0) PG8_BAR; }
    PG8_BAR;
    if constexpr (Epi::AFTER_DRAIN) { E.fused(acc, cur, wr, wc, fr, fq, lds, wid, lane); S.done(cur); }
#undef PG8_SA
#undef PG8_SB
#undef PG8_STAGE
#undef PG8_LDA
#undef PG8_LDB
#undef PG8_MMA
#undef PG8_WAIT_V
#undef PG8_WAIT_L
#undef PG8_BAR
#undef PG8_SCHED
}
}

#define LAS __attribute__((address_space(3)))
typedef unsigned short bf16_t;
typedef short bf16x8 __attribute__((ext_vector_type(8)));
typedef float f32x4 __attribute__((ext_vector_type(4)));
typedef unsigned u32x4 __attribute__((ext_vector_type(4)));
typedef unsigned u32x2 __attribute__((ext_vector_type(2)));

constexpr int DM = 2048, NB = 4, SEQ = 2048, DEPTH = 2, NS = 128;
constexpr int MPROMPT = NB * SEQ, MV = MPROMPT + NS, MPAD = 8448;
constexpr int WA = 1024, WB = 512, WC = 512, KB = 31;
constexpr int DIN = 4096, DFF = 8192;
constexpr int ZXA = 0, ZGA = 1024, ZXB = 2048, ZGB = 2560, ZUC = 3072, ZVC = 3584;
constexpr int MYA = 0, MYB = 1024, MYC = 1536;
constexpr float EPS = 1e-6f;
constexpr size_t O_YP = 0, O_YS = 16777216, O_CAP = O_YS + 262144, O_HP = O_CAP + 24576, O_CBP = O_HP + 8192, O_CAS = O_CBP + 122880,
                 O_HS = O_CAS + 786432, O_CBS = O_HS + 262144, O_VS = O_CBS + 3932160;
enum { I_XP = 0, I_XS, I_SCA, I_SH, I_SCB, I_NMIX, I_WIN, I_CAW, I_CAB, I_GRW, I_GRB, I_GIW, I_GIB, I_LAM, I_CBW, I_LNBG, I_LNBB, I_SLG, I_SLB, I_SW, I_SB, I_WOUT, I_NFFN, I_WFF1, I_WFF2, I_NFIN, N_INPUTS };
constexpr size_t MiB = 1u << 20;
constexpr size_t WS_WIN = 1 * MiB, WS_WOUT = 33 * MiB, WS_WFF1 = 49 * MiB, WS_WFF2 = 113 * MiB, WS_GATE = 177 * MiB, WS_SGUW = 178 * MiB, WS_CARRY = 179 * MiB;
constexpr size_t WS_X = 180 * MiB, WS_HN = 246 * MiB, WS_Z = 279 * MiB, WS_MIX = 345 * MiB, WS_HLOC = 378 * MiB, WS_PCUM = 394 * MiB, WS_FF = 279 * MiB, WS_PART = 411 * MiB, WS_END = 419 * MiB, WS_QCTR = 16384, WS_RS = 65536;
constexpr int LDS_BYTES = 147456;

struct Args { const float* in[N_INPUTS]; float* out; unsigned char* ws; int ph_lo, ph_hi; };

__device__ __forceinline__ unsigned f2bf(float f) { unsigned u = __builtin_bit_cast(unsigned, f); return (u + 0x7fffu + ((u >> 16) & 1u)) >> 16; }
__device__ __forceinline__ unsigned pk2(float lo, float hi) { unsigned r; asm("v_cvt_pk_bf16_f32 %0, %1, %2" : "=v"(r) : "v"(lo), "v"(hi)); return r; }
__device__ __forceinline__ float bflo(unsigned w) { return __builtin_bit_cast(float, w << 16); }
__device__ __forceinline__ float bfhi(unsigned w) { return __builtin_bit_cast(float, w & 0xffff0000u); }
__device__ __forceinline__ float bf1(bf16_t h) { return __builtin_bit_cast(float, (unsigned)h << 16); }
__device__ __forceinline__ void unpack8(const u32x4 w, float (&v)[8]) { v[0] = bflo(w.x); v[1] = bfhi(w.x); v[2] = bflo(w.y); v[3] = bfhi(w.y); v[4] = bflo(w.z); v[5] = bfhi(w.z); v[6] = bflo(w.w); v[7] = bfhi(w.w); }
__device__ __forceinline__ u32x4 pack8(const float (&v)[8]) { u32x4 w; w.x = pk2(v[0], v[1]); w.y = pk2(v[2], v[3]); w.z = pk2(v[4], v[5]); w.w = pk2(v[6], v[7]); return w; }
__device__ __forceinline__ float frcp(float x) { return __builtin_amdgcn_rcpf(x); }
__device__ __forceinline__ float sigmoidf_(float x) { return frcp(1.0f + __expf(-x)); }
__device__ __forceinline__ float gelu_t(float x) { const float y = 1.5957691216f * (x + 0.044715f * x * x * x); return x * frcp(1.0f + __expf(-y)); }
__device__ __forceinline__ int opaque_tid() { int t = threadIdx.x; asm volatile("" : "+v"(t)); return t; }
__device__ __forceinline__ float wave_sum(float v) {
#pragma unroll
    for (int o = 1; o < 64; o <<= 1) v += __shfl_xor(v, o);
    return v;
}


__device__ __forceinline__ void transpose_item(const float* __restrict__ W, int K, int N, bf16_t* __restrict__ WT, LAS float* scr, int item, int lane, const float* __restrict__ gk = nullptr) {
    const int nblk = N >> 6, kb = item / nblk, nb = item - kb * nblk, k0 = kb << 6, n0 = nb << 6;
    const int rr = lane >> 4, c4 = (lane & 15) << 2;
#pragma unroll 4
    for (int i = 0; i < 16; ++i) { const int kk = 4 * i + rr; f32x4 v = *(const f32x4*)(W + (size_t)(k0 + kk) * N + n0 + c4); if (gk) v = v * gk[k0 + kk];
        scr[kk * 65 + c4 + 0] = v[0]; scr[kk * 65 + c4 + 1] = v[1]; scr[kk * 65 + c4 + 2] = v[2]; scr[kk * 65 + c4 + 3] = v[3]; }
    asm volatile("s_waitcnt lgkmcnt(0)" ::: "memory");
    const int c = lane & 7;
#pragma unroll
    for (int j = 0; j < 8; ++j) { const int n = (lane >> 3) + 8 * j; const LAS float* s = scr + (8 * c) * 65 + n;
        u32x4 o; o.x = pk2(s[0 * 65], s[1 * 65]); o.y = pk2(s[2 * 65], s[3 * 65]); o.z = pk2(s[4 * 65], s[5 * 65]); o.w = pk2(s[6 * 65], s[7 * 65]);
        *(u32x4*)(WT + (size_t)(n0 + n) * K + k0 + 8 * c) = o; }
    asm volatile("s_waitcnt lgkmcnt(0)" ::: "memory");
}

__device__ __forceinline__ void phase_prep(const Args& a, LAS unsigned char* lds, int bid, int NGW) {
    const int tid = opaque_tid(), lane = tid & 63, wave = __builtin_amdgcn_readfirstlane(tid >> 6), gw = bid * 8 + wave;
    LAS float* scr = (LAS float*)(lds + wave * 16640);
    constexpr int I_IN = (DM / 64) * (DIN / 64), I_OUT = (DM / 64) * (DM / 64), I_F1 = (DM / 64) * (DFF / 64), I_F2 = (DFF / 64) * (DM / 64), I_G = 2 * 8 * 4;
    constexpr int PER_LAYER = I_IN + I_OUT + I_F1 + I_F2 + I_G;
    for (int it = gw; it < DEPTH * PER_LAYER; it += NGW) {
        const int l = it / PER_LAYER; int r = it - l * PER_LAYER;
        if (r < I_IN) { transpose_item(a.in[I_WIN] + (size_t)l * DM * DIN, DM, DIN, (bf16_t*)(a.ws + WS_WIN) + (size_t)l * DM * DIN, scr, r, lane, a.in[I_NMIX] + (size_t)l * DM); continue; } r -= I_IN;
        if (r < I_OUT) { transpose_item(a.in[I_WOUT] + (size_t)l * DM * DM, DM, DM, (bf16_t*)(a.ws + WS_WOUT) + (size_t)l * DM * DM, scr, r, lane); continue; } r -= I_OUT;
        if (r < I_F1) { transpose_item(a.in[I_WFF1] + (size_t)l * DM * DFF, DM, DFF, (bf16_t*)(a.ws + WS_WFF1) + (size_t)l * DM * DFF, scr, r, lane, a.in[I_NFFN] + (size_t)l * DM); continue; } r -= I_F1;
        if (r < I_F2) { transpose_item(a.in[I_WFF2] + (size_t)l * DM * DFF, DFF, DM, (bf16_t*)(a.ws + WS_WFF2) + (size_t)l * DM * DFF, scr, r, lane); continue; } r -= I_F2;
        { const int g = r >> 5, h = (r >> 2) & 7, sub = r & 3;
          const float* src = (g ? a.in[I_GIW] : a.in[I_GRW]) + ((size_t)l * 8 + h) * 16384;
          bf16_t* dst = (bf16_t*)(a.ws + WS_GATE) + (((size_t)l * 2 + g) * 8 + h) * 16384;
          transpose_item(src, 128, 128, dst, scr, sub, lane); }
    }
    const float* sw = a.in[I_SW]; bf16_t* so = (bf16_t*)(a.ws + WS_SGUW);
    for (int i = gw * 64 + lane; i < DEPTH * 4 * 128 * 128; i += NGW * 64) { const int s = i & 127, t = (i >> 7) & 127; so[i] = (bf16_t)(s <= t ? f2bf(sw[i]) : 0u); }
}

__device__ __forceinline__ void phase_rms(const float* xp, const float* xs, const float* __restrict__ g, bf16_t* obf, float* of32, int bid, int NGW, const float* part = nullptr, float* xs_wb = nullptr, float* rss_out = nullptr) {
#ifdef DIS_R
    return;
#endif
    const int tid = opaque_tid(), lane = tid & 63, gw = bid * 8 + __builtin_amdgcn_readfirstlane(tid >> 6);
    f32x4 gv[8];
#pragma unroll
    for (int j = 0; j < 8; ++j) gv[j] = ((const f32x4*)g)[lane + 64 * j];
    for (int r = gw; r < MV; r += NGW) {
        const f32x4* xr = (const f32x4*)(r < MPROMPT ? xp + (size_t)r * DM : xs + (size_t)(r - MPROMPT) * DM);
        f32x4 v[8]; float ss = 0.f;
#pragma unroll
        for (int j = 0; j < 8; ++j) v[j] = xr[lane + 64 * j];
        if (part && r >= MPROMPT) {
#pragma unroll 1
            for (int ks = 0; ks < 8; ks += 2) { const f32x4* pr = (const f32x4*)(part + ((size_t)ks * NS + (r - MPROMPT)) * DM); const f32x4* pr2 = pr + (size_t)NS * DM / 4;
                f32x4 t0[8], t1[8];
#pragma unroll
                for (int j = 0; j < 8; ++j) { t0[j] = pr[lane + 64 * j]; t1[j] = pr2[lane + 64 * j]; }
                __builtin_amdgcn_sched_barrier(0);
#pragma unroll
                for (int j = 0; j < 8; ++j) v[j] += t0[j] + t1[j]; }
            f32x4* wb = (f32x4*)(xs_wb + (size_t)(r - MPROMPT) * DM);
#pragma unroll
            for (int j = 0; j < 8; ++j) wb[lane + 64 * j] = v[j];
        }
#pragma unroll
        for (int j = 0; j < 8; ++j) ss += (v[j][0] * v[j][0] + v[j][1] * v[j][1]) + (v[j][2] * v[j][2] + v[j][3] * v[j][3]);
        ss = wave_sum(ss);
        if (rss_out) {
            u32x2* o = (u32x2*)(obf + (size_t)r * DM);
#pragma unroll
            for (int j = 0; j < 8; ++j) { u32x2 w; w.x = pk2(v[j][0], v[j][1]); w.y = pk2(v[j][2], v[j][3]); o[lane + 64 * j] = w; }
            if (lane == 0) rss_out[r] = ss;
            continue;
        }
        const float rstd = 1.0f / sqrtf(ss * (1.0f / DM) + EPS);
        if (obf) { u32x2* o = (u32x2*)(obf + (size_t)r * DM);
#pragma unroll
            for (int j = 0; j < 8; ++j) { const f32x4 y = v[j] * rstd * gv[j]; u32x2 w; w.x = pk2(y[0], y[1]); w.y = pk2(y[2], y[3]); o[lane + 64 * j] = w; }
        } else { f32x4* o = (f32x4*)(of32 + (size_t)r * DM);
#pragma unroll
            for (int j = 0; j < 8; ++j) o[lane + 64 * j] = v[j] * rstd * gv[j]; }
    }
}

__device__ __forceinline__ void mixA_item(const Args& a, LAS unsigned char* lds, int l, int item) {
    const int tid = opaque_tid(), lane = tid & 63, wid = __builtin_amdgcn_readfirstlane(tid >> 6);
    const bool samp = item >= 512;
    const int tt = samp ? 64 : (item >> 3), h = samp ? (item - 512) : (item & 7);
    const int ti = tt & 15, r0 = tt * 128, c0 = h * 128, bseq = tt >> 4;
    const bf16_t* Z = (const bf16_t*)(a.ws + WS_Z);
    LAS bf16_t* AT = (LAS bf16_t*)lds;
    LAS float* AA = (LAS float*)lds;
    LAS float* UU = (LAS float*)(lds + 67584);
    LAS float* SP = (LAS float*)(lds + 135168);
    LAS float* SH = SP + 512;
    LAS float* CP = SH + 512;
    LAS float* CH = CP + 512;
    const float* caw = a.in[I_CAW] + (size_t)l * 4 * WA; const float* cab = a.in[I_CAB] + (size_t)l * WA;
    const int fr = lane & 15, fq = lane >> 4;
    bf16x8 gbr[4], gbi[4]; float brb_c, bib_c, lam_c;
    { const bf16_t* GR = (const bf16_t*)(a.ws + WS_GATE) + (((size_t)l * 2 + 0) * 8 + h) * 16384 + (size_t)(16 * wid + fr) * 128 + fq * 8;
      const bf16_t* GI = (const bf16_t*)(a.ws + WS_GATE) + (((size_t)l * 2 + 1) * 8 + h) * 16384 + (size_t)(16 * wid + fr) * 128 + fq * 8;
#pragma unroll
      for (int ks = 0; ks < 4; ++ks) { gbr[ks] = *(const bf16x8*)(GR + ks * 32); gbi[ks] = *(const bf16x8*)(GI + ks * 32); }
      const int c = c0 + 16 * wid + fr; brb_c = a.in[I_GRB][(size_t)l * WA + c]; bib_c = a.in[I_GIB][(size_t)l * WA + c]; lam_c = a.in[I_LAM][(size_t)l * WA + c]; }
    {
        const int kc = (tid & 15) * 8, c = c0 + kc, tb = tid >> 4;
        float wv[4][8], bias[8];
        { const f32x4 b0 = *(const f32x4*)(cab + c), b1 = *(const f32x4*)(cab + c + 4);
#pragma unroll
          for (int e = 0; e < 4; ++e) { bias[e] = b0[e]; bias[4 + e] = b1[e]; }
#pragma unroll
          for (int j = 0; j < 4; ++j) { const f32x4 w0 = *(const f32x4*)(caw + (size_t)j * WA + c), w1 = *(const f32x4*)(caw + (size_t)j * WA + c + 4);
#pragma unroll
              for (int e = 0; e < 4; ++e) { wv[j][e] = w0[e]; wv[j][4 + e] = w1[e]; } } }
        if (!samp) {
            u32x4 zr[4][4];
#pragma unroll
            for (int i = 0; i < 4; ++i)
#pragma unroll
                for (int j = 0; j < 4; ++j) { const int tr = tb + 32 * i - 3 + j; const int trc = (ti * 128 + tr >= 0) ? tr : 0;
                    zr[i][j] = *(const u32x4*)(Z + (size_t)(r0 + trc) * DIN + ZXA + c); }
            __builtin_amdgcn_sched_barrier(0);
#pragma unroll
            for (int i = 0; i < 4; ++i) { const int t = tb + 32 * i; float acc[8];
#pragma unroll
                for (int e = 0; e < 8; ++e) acc[e] = bias[e];
#pragma unroll
                for (int j = 0; j < 4; ++j) { float xv[8]; unpack8(zr[i][j], xv); const float msk = (ti * 128 + t - 3 + j >= 0) ? 1.f : 0.f;
#pragma unroll
                    for (int e = 0; e < 8; ++e) acc[e] += wv[j][e] * (xv[e] * msk);
                    if (j == 3 && ti == 15 && t >= 125) { float* o = a.out + O_CAP + (((size_t)l * NB + bseq) * 3 + (t - 125)) * WA + c;
                        *(f32x4*)o = (f32x4){xv[0], xv[1], xv[2], xv[3]}; *(f32x4*)(o + 4) = (f32x4){xv[4], xv[5], xv[6], xv[7]}; } }
                *(LAS u32x4*)(AT + t * 136 + kc) = pack8(acc); }
        } else {
            u32x4 zr[4]; f32x4 sv[4][3][2];
#pragma unroll
            for (int i = 0; i < 4; ++i) { const int t = tb + 32 * i; zr[i] = *(const u32x4*)(Z + (size_t)(MPROMPT + t) * DIN + ZXA + c);
#pragma unroll
                for (int j = 0; j < 3; ++j) { const float* sp = a.in[I_SCA] + (((size_t)l * NS + t) * 3 + j) * WA + c; sv[i][j][0] = *(const f32x4*)sp; sv[i][j][1] = *(const f32x4*)(sp + 4); } }
            __builtin_amdgcn_sched_barrier(0);
#pragma unroll
            for (int i = 0; i < 4; ++i) { const int t = tb + 32 * i; float acc[8];
#pragma unroll
                for (int e = 0; e < 8; ++e) acc[e] = bias[e];
#pragma unroll
                for (int j = 0; j < 4; ++j) { float xv[8];
                    if (j < 3) {
#pragma unroll
                        for (int e = 0; e < 4; ++e) { xv[e] = sv[i][j][0][e]; xv[4 + e] = sv[i][j][1][e]; } }
                    else unpack8(zr[i], xv);
#pragma unroll
                    for (int e = 0; e < 8; ++e) acc[e] += wv[j][e] * xv[e];
                    if (j >= 1) { float* o = a.out + O_CAS + (((size_t)l * NS + t) * 3 + (j - 1)) * WA + c;
                        *(f32x4*)o = (f32x4){xv[0], xv[1], xv[2], xv[3]}; *(f32x4*)(o + 4) = (f32x4){xv[4], xv[5], xv[6], xv[7]}; } }
                *(LAS u32x4*)(AT + t * 136 + kc) = pack8(acc); }
        }
    }
    __syncthreads();
    f32x4 accr[8], acci[8];
#pragma unroll
    for (int m = 0; m < 8; ++m) { accr[m] = (f32x4){0.f, 0.f, 0.f, 0.f}; acci[m] = (f32x4){0.f, 0.f, 0.f, 0.f}; }
#pragma unroll
    for (int ks = 0; ks < 4; ++ks) {
#pragma unroll
        for (int m = 0; m < 8; ++m) {
            const bf16x8 af = *(const LAS bf16x8*)(AT + (16 * m + fr) * 136 + ks * 32 + fq * 8);
            accr[m] = __builtin_amdgcn_mfma_f32_16x16x32_bf16(af, gbr[ks], accr[m], 0, 0, 0);
            acci[m] = __builtin_amdgcn_mfma_f32_16x16x32_bf16(af, gbi[ks], acci[m], 0, 0, 0);
        }
    }
    {
        const float LP = -8.0f * log1pf(expf(-lam_c));
#pragma unroll
        for (int m = 0; m < 8; ++m) {
#pragma unroll
            for (int j = 0; j < 4; ++j) {
                const int t = 16 * m + 4 * fq + j;
                const float xc = bf1(AT[t * 136 + 16 * wid + fr]);
                const float rg = sigmoidf_(accr[m][j] + brb_c), ig = sigmoidf_(acci[m][j] + bib_c);
                const float la = rg * LP, x2 = 2.0f * la;
                const float av = __expf(la);
                const float ser = -x2 * (1.0f + x2 * (0.5f + x2 * (0.16666667f + x2 * (0.041666668f + x2 * (0.0083333338f + x2 * 0.0013888889f)))));
                const float om = x2 > -0.25f ? ser : 1.0f - av * av;
                accr[m][j] = av;
                acci[m][j] = __builtin_amdgcn_sqrtf(om) * (ig * xc);
            }
        }
    }
    __syncthreads();
#pragma unroll
    for (int m = 0; m < 8; ++m)
#pragma unroll
        for (int j = 0; j < 4; ++j) { const int t = 16 * m + 4 * fq + j; AA[t * 132 + 16 * wid + fr] = accr[m][j]; UU[t * 132 + 16 * wid + fr] = acci[m][j]; }
    __syncthreads();
    if (!samp) {
        { const int k = tid & 127, seg = tid >> 7; float P = 1.f, hl = 0.f;
#pragma unroll 8
          for (int q = 0; q < 32; ++q) { const int t = 32 * seg + q; const float av = AA[t * 132 + k], uv = UU[t * 132 + k]; P *= av; hl = av * hl + uv; AA[t * 132 + k] = P; UU[t * 132 + k] = hl; }
          SP[seg * 128 + k] = P; SH[seg * 128 + k] = hl;
          __syncthreads();
          float Pc = 1.f, Hc = 0.f;
          for (int s = 0; s < seg; ++s) { const float ps = SP[s * 128 + k], hs = SH[s * 128 + k]; Hc = ps * Hc + hs; Pc *= ps; }
          CP[seg * 128 + k] = Pc; CH[seg * 128 + k] = Hc;
          if (seg == 3) { float* ca = (float*)(a.ws + WS_CARRY); ca[(size_t)tt * WA + c0 + k] = Pc * P; ca[(size_t)(64 + tt) * WA + c0 + k] = P * Hc + hl; }
          __syncthreads(); }
        bf16_t* HL = (bf16_t*)(a.ws + WS_HLOC); bf16_t* PL = (bf16_t*)(a.ws + WS_PCUM);
#pragma unroll
        for (int i = 0; i < 4; ++i) {
            const int chunk = tid + 512 * i, t = chunk >> 4, kc = (chunk & 15) * 8, sg = t >> 5;
            float hv[8], pv[8];
            const f32x4 p0 = *(const LAS f32x4*)(AA + t * 132 + kc), p1 = *(const LAS f32x4*)(AA + t * 132 + kc + 4), h0 = *(const LAS f32x4*)(UU + t * 132 + kc), h1 = *(const LAS f32x4*)(UU + t * 132 + kc + 4);
            const f32x4 cp0 = *(const LAS f32x4*)(CP + sg * 128 + kc), cp1 = *(const LAS f32x4*)(CP + sg * 128 + kc + 4), ch0 = *(const LAS f32x4*)(CH + sg * 128 + kc), ch1 = *(const LAS f32x4*)(CH + sg * 128 + kc + 4);
#pragma unroll
            for (int e = 0; e < 4; ++e) { hv[e] = h0[e] + p0[e] * ch0[e]; pv[e] = p0[e] * cp0[e]; hv[4 + e] = h1[e] + p1[e] * ch1[e]; pv[4 + e] = p1[e] * cp1[e]; }
            *(u32x4*)(HL + (size_t)(r0 + t) * WA + c0 + kc) = pack8(hv);
            *(u32x4*)(PL + (size_t)(r0 + t) * WA + c0 + kc) = pack8(pv);
        }
    } else {
        bf16_t* MIX = (bf16_t*)(a.ws + WS_MIX);
#pragma unroll
        for (int i = 0; i < 4; ++i) {
            const int chunk = tid + 512 * i, b = chunk >> 4, kc = (chunk & 15) * 8, c = c0 + kc;
            const float* h0 = a.in[I_SH] + ((size_t)l * NS + b) * WA + c; const f32x4 h00 = *(const f32x4*)h0, h01 = *(const f32x4*)(h0 + 4);
            float ga[8]; unpack8(*(const u32x4*)(Z + (size_t)(MPROMPT + b) * DIN + ZGA + c), ga);
            float hv[8], yv[8];
#pragma unroll
            for (int e = 0; e < 8; ++e) { const float hp = e < 4 ? h00[e & 3] : h01[e & 3]; hv[e] = AA[b * 132 + kc + e] * hp + UU[b * 132 + kc + e]; yv[e] = hv[e] * gelu_t(ga[e]); }
            float* ho = a.out + O_HS + ((size_t)l * NS + b) * WA + c;
            *(f32x4*)ho = (f32x4){hv[0], hv[1], hv[2], hv[3]}; *(f32x4*)(ho + 4) = (f32x4){hv[4], hv[5], hv[6], hv[7]};
            *(u32x4*)(MIX + (size_t)(MPROMPT + b) * DM + MYA + c) = pack8(yv);
        }
    }
    __syncthreads();
}

__device__ __forceinline__ void mixA2_item(const Args& a, LAS unsigned char* lds, int l, int item) {
    const int tid = opaque_tid();
    const int tt = item >> 3, h = item & 7, ti = tt & 15, r0 = tt * 128, c0 = h * 128, bseq = tt >> 4;
    LAS float* HIN = (LAS float*)lds;
    const float* ca = (const float*)(a.ws + WS_CARRY);
    if (tid < 128) { float Hc = 0.f; float ca_[15], ch_[15];
#pragma unroll
        for (int j = 0; j < 15; ++j) { const int t2 = tt - ti + (j < ti ? j : 0); ca_[j] = ca[(size_t)t2 * WA + c0 + tid]; ch_[j] = ca[(size_t)(64 + t2) * WA + c0 + tid]; }
        __builtin_amdgcn_sched_barrier(0);
#pragma unroll
        for (int j = 0; j < 15; ++j) { const float aj = j < ti ? ca_[j] : 1.f, hj = j < ti ? ch_[j] : 0.f; Hc = aj * Hc + hj; }
        HIN[tid] = Hc;
        if (ti == 15) a.out[O_HP + ((size_t)l * NB + bseq) * WA + c0 + tid] = ca[(size_t)tt * WA + c0 + tid] * Hc + ca[(size_t)(64 + tt) * WA + c0 + tid]; }
    __syncthreads();
    const bf16_t* Z = (const bf16_t*)(a.ws + WS_Z); const bf16_t* HL = (const bf16_t*)(a.ws + WS_HLOC); const bf16_t* PL = (const bf16_t*)(a.ws + WS_PCUM); bf16_t* MIX = (bf16_t*)(a.ws + WS_MIX);
    {   const int kc = (tid & 15) * 8, c = c0 + kc, tb = tid >> 4;
        u32x4 hr[4], pr[4], gr[4];
#pragma unroll
        for (int i = 0; i < 4; ++i) { const size_t row = (size_t)(r0 + tb + 32 * i); hr[i] = *(const u32x4*)(HL + row * WA + c); pr[i] = *(const u32x4*)(PL + row * WA + c); gr[i] = *(const u32x4*)(Z + row * DIN + ZGA + c); }
        __builtin_amdgcn_sched_barrier(0);
#pragma unroll
        for (int i = 0; i < 4; ++i) { float hv[8], pv[8], ga[8], yv[8]; unpack8(hr[i], hv); unpack8(pr[i], pv); unpack8(gr[i], ga);
#pragma unroll
            for (int e = 0; e < 8; ++e) yv[e] = (hv[e] + pv[e] * HIN[kc + e]) * gelu_t(ga[e]);
            *(u32x4*)(MIX + (size_t)(r0 + tb + 32 * i) * DM + MYA + c) = pack8(yv); }
    }
    __syncthreads();
}

__device__ __forceinline__ void lnB_rows(const Args& a, LAS float* Y, int l, int ntok, int row0, int wid, int lane) {
    const float* g = a.in[I_LNBG] + (size_t)l * WB; const float* bb = a.in[I_LNBB] + (size_t)l * WB; bf16_t* MIX = (bf16_t*)(a.ws + WS_MIX);
    float gg[8], bv[8];
#pragma unroll
    for (int i = 0; i < 8; ++i) { gg[i] = g[lane + 64 * i]; bv[i] = bb[lane + 64 * i]; }
    __builtin_amdgcn_sched_barrier(0);
    if (ntok == 32) {
        float v[4][8], s[4], q[4];
#pragma unroll
        for (int k = 0; k < 4; ++k) { s[k] = 0.f;
#pragma unroll
            for (int i = 0; i < 8; ++i) { v[k][i] = Y[(wid + 8 * k) * 512 + lane + 64 * i]; s[k] += v[k][i]; } }
#pragma unroll
        for (int o = 1; o < 64; o <<= 1) {
#pragma unroll
            for (int k = 0; k < 4; ++k) s[k] += __shfl_xor(s[k], o); }
#pragma unroll
        for (int k = 0; k < 4; ++k) { const float mean = s[k] * (1.0f / WB); q[k] = 0.f;
#pragma unroll
            for (int i = 0; i < 8; ++i) { v[k][i] -= mean; q[k] += v[k][i] * v[k][i]; } }
#pragma unroll
        for (int o = 1; o < 64; o <<= 1) {
#pragma unroll
            for (int k = 0; k < 4; ++k) q[k] += __shfl_xor(q[k], o); }
#pragma unroll
        for (int k = 0; k < 4; ++k) { const float rstd = 1.0f / sqrtf(q[k] * (1.0f / WB) + EPS);
#pragma unroll
            for (int i = 0; i < 8; ++i) { const int c = lane + 64 * i; const float o = v[k][i] * rstd * gg[i] + bv[i]; MIX[(size_t)(row0 + wid + 8 * k) * DM + MYB + c] = (bf16_t)f2bf(o * sigmoidf_(o)); } }
        return;
    }
    for (int t = wid; t < ntok; t += 8) {
        float v[8]; float s = 0.f;
#pragma unroll
        for (int i = 0; i < 8; ++i) { v[i] = Y[t * 512 + lane + 64 * i]; s += v[i]; }
        const float mean = wave_sum(s) * (1.0f / WB); float q = 0.f;
#pragma unroll
        for (int i = 0; i < 8; ++i) { v[i] -= mean; q += v[i] * v[i]; }
        const float rstd = 1.0f / sqrtf(wave_sum(q) * (1.0f / WB) + EPS);
#pragma unroll
        for (int i = 0; i < 8; ++i) { const int c = lane + 64 * i; const float o = v[i] * rstd * gg[i] + bv[i]; MIX[(size_t)(row0 + t) * DM + MYB + c] = (bf16_t)f2bf(o * sigmoidf_(o)); }
    }
}
__device__ __forceinline__ void mixB_item(const Args& a, LAS unsigned char* lds, int l, int item) {
    const int tid = opaque_tid(), lane = tid & 63, wid = __builtin_amdgcn_readfirstlane(tid >> 6);
    const bf16_t* Z = (const bf16_t*)(a.ws + WS_Z);
    LAS float* Y = (LAS float*)lds;
    const int c = tid;
    float w[31];
#pragma unroll
    for (int j = 0; j < 31; ++j) w[j] = a.in[I_CBW][((size_t)l * KB + j) * WB + c];
    if (item < 256) {
        const int bseq = item >> 6, tq = item & 63, r0 = item * 32;
        float ub[62];
        { bf16_t xr[62], gr[62];
#pragma unroll
          for (int k = 0; k < 62; ++k) { const int pos = tq * 32 + k - 30; const size_t ro = (size_t)(bseq * SEQ + (pos >= 0 ? pos : 0)) * DIN; xr[k] = Z[ro + ZXB + c]; gr[k] = Z[ro + ZGB + c]; }
          __builtin_amdgcn_sched_barrier(0);
#pragma unroll
          for (int k = 0; k < 62; ++k) { const int pos = tq * 32 + k - 30; const float v = bf1(xr[k]) * sigmoidf_(bf1(gr[k])); ub[k] = pos >= 0 ? v : 0.f; } }
#pragma unroll
        for (int t = 0; t < 32; ++t) { float y = 0.f;
#pragma unroll
            for (int j = 0; j < 31; ++j) y += w[j] * ub[t + j];
            Y[t * 512 + c] = y; }
        if (tq == 63) {
#pragma unroll
            for (int j = 0; j < 30; ++j) a.out[O_CBP + (((size_t)l * NB + bseq) * 30 + j) * WB + c] = ub[32 + j]; }
        __syncthreads();
        lnB_rows(a, Y, l, 32, r0, wid, lane);
    } else {
        const int is = item - 256;
#pragma unroll 1
        for (int q = 0; q < 4; ++q) {
            const int b = is * 4 + q; float y = 0.f;
            const float* st = a.in[I_SCB] + ((size_t)l * NS + b) * 30 * WB + c; float* co = a.out + O_CBS + ((size_t)l * NS + b) * 30 * WB + c;
            float sv[30];
#pragma unroll
            for (int j = 0; j < 30; ++j) sv[j] = st[(size_t)j * WB];
            const size_t ro = (size_t)(MPROMPT + b) * DIN; const bf16_t xbr = Z[ro + ZXB + c], gbr = Z[ro + ZGB + c];
            __builtin_amdgcn_sched_barrier(0);
#pragma unroll
            for (int j = 0; j < 30; ++j) { y += w[j] * sv[j]; if (j >= 1) co[(size_t)(j - 1) * WB] = sv[j]; }
            const float un = bf1(xbr) * sigmoidf_(bf1(gbr));
            y += w[30] * un; co[(size_t)29 * WB] = un;
            Y[q * 512 + c] = y;
        }
        __syncthreads();
        lnB_rows(a, Y, l, 4, MPROMPT + is * 4, wid, lane);
    }
    __syncthreads();
}

__device__ __forceinline__ void mixC_item(const Args& a, LAS unsigned char* lds, int l, int item) {
    const int tid = opaque_tid(), lane = tid & 63, wid = __builtin_amdgcn_readfirstlane(tid >> 6);
    const bf16_t* Z = (const bf16_t*)(a.ws + WS_Z); bf16_t* MIX = (bf16_t*)(a.ws + WS_MIX);
    const float* lg = a.in[I_SLG] + (size_t)l * WC; const float* lb = a.in[I_SLB] + (size_t)l * WC;
    if (item < 256) {
        const int tt = item >> 2, h = item & 3, r0 = tt * 128;
        LAS float* ST = (LAS float*)lds;
        LAS bf16_t* VT = (LAS bf16_t*)(lds + 1024);
        {
            u32x4 zr[16];
#pragma unroll
            for (int tk = 0; tk < 16; ++tk) zr[tk] = *(const u32x4*)(Z + (size_t)(r0 + 16 * wid + tk) * DIN + ZVC + lane * 8);
            __builtin_amdgcn_sched_barrier(0);
            float s1[16], s2[16];
#pragma unroll
            for (int tk = 0; tk < 16; ++tk) { float v[8]; unpack8(zr[tk], v); float p = 0.f, q = 0.f;
#pragma unroll
                for (int e = 0; e < 8; ++e) { const float gv = gelu_t(v[e]); p += gv; q += gv * gv; }
                s1[tk] = p; s2[tk] = q; }
#pragma unroll
            for (int o = 1; o < 64; o <<= 1) {
#pragma unroll
                for (int tk = 0; tk < 16; ++tk) { s1[tk] += __shfl_xor(s1[tk], o); s2[tk] += __shfl_xor(s2[tk], o); } }
#pragma unroll
            for (int tk = 0; tk < 16; ++tk) if (lane == tk) { const float mean = s1[tk] * (1.0f / WC); const float var = fmaxf(s2[tk] * (1.0f / WC) - mean * mean, 0.f);
                ST[2 * (16 * wid + tk)] = mean; ST[2 * (16 * wid + tk) + 1] = 1.0f / sqrtf(var + EPS); }
        }
        __syncthreads();
        {   const int dc = (tid & 15) * 8, cc = h * 128 + dc, sb = tid >> 4;
            u32x4 zr[4];
#pragma unroll
            for (int i = 0; i < 4; ++i) zr[i] = *(const u32x4*)(Z + (size_t)(r0 + sb + 32 * i) * DIN + ZVC + cc);
            __builtin_amdgcn_sched_barrier(0);
            const f32x4 g0 = *(const f32x4*)(lg + cc), g1 = *(const f32x4*)(lg + cc + 4), b0 = *(const f32x4*)(lb + cc), b1 = *(const f32x4*)(lb + cc + 4);
#pragma unroll
            for (int i = 0; i < 4; ++i) { const int s = sb + 32 * i; float v[8]; unpack8(zr[i], v);
                const float mean = ST[2 * s], rstd = ST[2 * s + 1];
#pragma unroll
                for (int e = 0; e < 8; ++e) { const float gg = e < 4 ? g0[e & 3] : g1[e & 3], bv = e < 4 ? b0[e & 3] : b1[e & 3];
                    VT[(dc + e) * 136 + (s ^ ((tid & 15) << 3))] = (bf16_t)f2bf((gelu_t(v[e]) - mean) * rstd * gg + bv); } }
        }
        __syncthreads();
        const int fr = lane & 15, fq = lane >> 4;
        f32x4 acc[8];
#pragma unroll
        for (int n = 0; n < 8; ++n) acc[n] = (f32x4){0.f, 0.f, 0.f, 0.f};
        const bf16_t* SW = (const bf16_t*)(a.ws + WS_SGUW) + ((size_t)l * 4 + h) * 16384;
        const int nks = (16 * wid + 16 + 31) >> 5;
        for (int ks = 0; ks < nks; ++ks) {
            const bf16x8 wf = *(const bf16x8*)(SW + (size_t)(16 * wid + fr) * 128 + ks * 32 + fq * 8);
#pragma unroll
            for (int n = 0; n < 8; ++n) { const bf16x8 vf = *(const LAS bf16x8*)(VT + (n * 16 + fr) * 136 + (((ks * 4 + fq) ^ (2 * n + (fr >> 3))) << 3));
                acc[n] = __builtin_amdgcn_mfma_f32_16x16x32_bf16(vf, wf, acc[n], 0, 0, 0); }
        }
        const int t = 16 * wid + fr; const float bs = a.in[I_SB][((size_t)l * 4 + h) * 128 + t]; const size_t row = (size_t)(r0 + t);
        u32x2 uwv[8];
#pragma unroll
        for (int n = 0; n < 8; ++n) uwv[n] = *(const u32x2*)(Z + row * DIN + ZUC + h * 128 + n * 16 + 4 * fq);
        __builtin_amdgcn_sched_barrier(0);
#pragma unroll
        for (int n = 0; n < 8; ++n) { const int d0 = n * 16 + 4 * fq; const u32x2 uw = uwv[n];
            const float u0 = gelu_t(bflo(uw.x)), u1 = gelu_t(bfhi(uw.x)), u2 = gelu_t(bflo(uw.y)), u3 = gelu_t(bfhi(uw.y));
            u32x2 o; o.x = pk2(u0 * (acc[n][0] + bs), u1 * (acc[n][1] + bs)); o.y = pk2(u2 * (acc[n][2] + bs), u3 * (acc[n][3] + bs));
            *(u32x2*)(MIX + row * DM + MYC + h * 128 + d0) = o; }
    } else {
        const int is = item - 256;
#pragma unroll 1
        for (int q = 0; q < 2; ++q) {
            const int b = is * 16 + wid * 2 + q; const size_t row = (size_t)(MPROMPT + b); const int cc = lane * 8, h = lane >> 4;
            float v[8]; unpack8(*(const u32x4*)(Z + row * DIN + ZVC + cc), v);
            float s = 0.f;
#pragma unroll
            for (int e = 0; e < 8; ++e) { v[e] = gelu_t(v[e]); s += v[e]; }
            const float mean = wave_sum(s) * (1.0f / WC); float qq = 0.f;
#pragma unroll
            for (int e = 0; e < 8; ++e) { v[e] -= mean; qq += v[e] * v[e]; }
            const float rstd = 1.0f / sqrtf(wave_sum(qq) * (1.0f / WC) + EPS);
            const f32x4 g0 = *(const f32x4*)(lg + cc), g1 = *(const f32x4*)(lg + cc + 4), b0 = *(const f32x4*)(lb + cc), b1 = *(const f32x4*)(lb + cc + 4);
            float uu[8]; unpack8(*(const u32x4*)(Z + row * DIN + ZUC + cc), uu);
            const float w00 = a.in[I_SW][((size_t)l * 4 + h) * 16384], bs = a.in[I_SB][((size_t)l * 4 + h) * 128];
            float yv[8];
#pragma unroll
            for (int e = 0; e < 8; ++e) { const float gg = e < 4 ? g0[e & 3] : g1[e & 3], bv = e < 4 ? b0[e & 3] : b1[e & 3]; v[e] = v[e] * rstd * gg + bv; yv[e] = gelu_t(uu[e]) * (w00 * v[e] + bs); }
            float* vo = a.out + O_VS + ((size_t)l * NS + b) * WC + cc;
            *(f32x4*)vo = (f32x4){v[0], v[1], v[2], v[3]}; *(f32x4*)(vo + 4) = (f32x4){v[4], v[5], v[6], v[7]};
            *(u32x4*)(MIX + row * DM + MYC + cc) = pack8(yv);
        }
    }
    __syncthreads();
}

constexpr int SK_AB = 128 * 72 * 2, SK_BB = 64 * 72 * 2, SK_STAGE = SK_AB + SK_BB;
template <int ACT  , int NT  >
__device__ __forceinline__ void skinny_gemm(LAS unsigned char* lds, const bf16_t* __restrict__ As, const bf16_t* __restrict__ Bt, int K, int N, int KSPLIT, bf16_t* obf, const float* base, float* of32, float* rss, int bid, int G) {
    const int tid = opaque_tid(), lane = tid & 63, wid = __builtin_amdgcn_readfirstlane(tid >> 6), fr = lane & 15, fq = lane >> 4;
    const int ncol = N / (16 * NT), nitems = ncol * KSPLIT, klen = K / KSPLIT, S = klen >> 6;
    const int lrow = tid >> 3, lkc = (tid & 7) * 8;
    for (int it = bid; it < nitems; it += G) {
        const int ct = it % ncol, ks = it / ncol, n0 = ct * (16 * NT), k0 = ks * klen; const bool bl = lrow < 16 * NT;
        const bf16_t* ag0 = As + (size_t)lrow * K + k0 + lkc;
        const bf16_t* ag1 = ag0 + (size_t)64 * K;
        const bf16_t* bg = Bt + (size_t)(n0 + (bl ? lrow : 0)) * K + k0 + lkc;
        u32x4 ra0[4], ra1[4], rb[4];
#pragma unroll
        for (int j = 0; j < 4; ++j) { ra0[j] = *(const u32x4*)(ag0 + j * 64); ra1[j] = *(const u32x4*)(ag1 + j * 64); rb[j] = *(const u32x4*)(bg + j * 64); }
        f32x4 acc[NT];
#pragma unroll
        for (int n = 0; n < NT; ++n) acc[n] = (f32x4){0.f, 0.f, 0.f, 0.f};
        for (int s0 = 0; s0 < S; s0 += 4) {
#pragma unroll
            for (int j = 0; j < 4; ++j) {
                LAS unsigned char* buf = lds + (j & 1) * SK_STAGE;
                LAS bf16_t* At = (LAS bf16_t*)buf; LAS bf16_t* Bs = (LAS bf16_t*)(buf + SK_AB);
                *(LAS u32x4*)(At + lrow * 72 + lkc) = ra0[j]; *(LAS u32x4*)(At + (64 + lrow) * 72 + lkc) = ra1[j]; if (bl) *(LAS u32x4*)(Bs + lrow * 72 + lkc) = rb[j];
                if (s0 + j + 4 < S) { const int ko = (s0 + j + 4) * 64; ra0[j] = *(const u32x4*)(ag0 + ko); ra1[j] = *(const u32x4*)(ag1 + ko); rb[j] = *(const u32x4*)(bg + ko); }
                __syncthreads();
                __builtin_amdgcn_s_setprio(1);
#pragma unroll
                for (int kk = 0; kk < 2; ++kk) {
                    const bf16x8 af = *(const LAS bf16x8*)(At + (16 * wid + fr) * 72 + kk * 32 + fq * 8);
#pragma unroll
                    for (int n = 0; n < NT; ++n) { const bf16x8 bf = *(const LAS bf16x8*)(Bs + (n * 16 + fr) * 72 + kk * 32 + fq * 8);
                        acc[n] = __builtin_amdgcn_mfma_f32_16x16x32_bf16(bf, af, acc[n], 0, 0, 0); }
                }
                __builtin_amdgcn_s_setprio(0);
            }
        }
        __syncthreads();
        const int r = 16 * wid + fr;
        f32x4 bsv[NT]; float rstd = 1.f, ss = 0.f;
        if (ACT == 3) {
#pragma unroll
            for (int n = 0; n < NT; ++n) bsv[n] = *(const f32x4*)(base + (size_t)r * N + n0 + n * 16 + 4 * fq);
            __builtin_amdgcn_sched_barrier(0); }
        if (ACT == 0 || ACT == 2) rstd = __builtin_amdgcn_rsqf(rss[r] * (1.0f / DM) + EPS);
#pragma unroll
        for (int n = 0; n < NT; ++n) {
            const int c = n0 + n * 16 + 4 * fq; f32x4 v = acc[n];
            if (ACT == 3) { v = v + bsv[n]; *(f32x4*)(of32 + (size_t)r * N + c) = v;
                u32x2 w; w.x = pk2(v[0], v[1]); w.y = pk2(v[2], v[3]); *(u32x2*)(obf + (size_t)r * N + c) = w; ss += (v[0] * v[0] + v[1] * v[1]) + (v[2] * v[2] + v[3] * v[3]); }
            else if (ACT == 4) { *(f32x4*)(of32 + ((size_t)ks * 128 + r) * N + c) = v; }
            else {
                v = v * rstd;
                if (ACT == 2) {
#pragma unroll
                    for (int e = 0; e < 4; ++e) { const float t = fmaxf(v[e], 0.f); v[e] = t * t; } }
                u32x2 w; w.x = pk2(v[0], v[1]); w.y = pk2(v[2], v[3]); *(u32x2*)(obf + (size_t)r * N + c) = w; }
        }
        if (ACT == 3) { ss += __shfl_xor(ss, 16); ss += __shfl_xor(ss, 32); if (fq == 0) atomicAdd(rss + r, ss); }
    }
}

__device__ __forceinline__ void sample_fold(const Args& a, int bid, float* rss, unsigned* flag) {
    const int tid = opaque_tid(), lane = tid & 63;
    if (bid < NS && tid < 64) {
        float* xr = (float*)(a.ws + WS_X) + (size_t)(MPROMPT + bid) * DM; bf16_t* hb = (bf16_t*)(a.ws + WS_HN) + (size_t)(MPROMPT + bid) * DM; const float* part = (const float*)(a.ws + WS_PART);
        f32x4 v[8]; float ss = 0.f;
#pragma unroll
        for (int j = 0; j < 8; ++j) v[j] = ((const f32x4*)xr)[lane + 64 * j];
#pragma unroll 1
        for (int ks = 0; ks < 8; ks += 2) { const f32x4* pr = (const f32x4*)(part + ((size_t)ks * NS + bid) * DM); const f32x4* pr2 = pr + (size_t)NS * DM / 4;
            f32x4 t0[8], t1[8];
#pragma unroll
            for (int j = 0; j < 8; ++j) { t0[j] = pr[lane + 64 * j]; t1[j] = pr2[lane + 64 * j]; }
            __builtin_amdgcn_sched_barrier(0);
#pragma unroll
            for (int j = 0; j < 8; ++j) v[j] += t0[j] + t1[j]; }
#pragma unroll
        for (int j = 0; j < 8; ++j) { ((f32x4*)xr)[lane + 64 * j] = v[j]; u32x2 w; w.x = pk2(v[j][0], v[j][1]); w.y = pk2(v[j][2], v[j][3]); ((u32x2*)hb)[lane + 64 * j] = w;
            ss += (v[j][0] * v[j][0] + v[j][1] * v[j][1]) + (v[j][2] * v[j][2] + v[j][3] * v[j][3]); }
        ss = wave_sum(ss);
        if (lane == 0) rss[bid] = ss;
        __threadfence();
        if (lane == 0) __hip_atomic_fetch_add(flag, 1u, __ATOMIC_RELAXED, __HIP_MEMORY_SCOPE_AGENT);
    }
}

#define XB_TMO      128
#define XB_XCNT(j)  (256  + 64 * (j))
#define XB_XSUB(j)  (1280 + 64 * (j))
#define XB_XGEN(j)  (2304 + 64 * (j))
#define XB_TOP      3328
#define XB_TOPGEN   3392
#define XCD_BAR_WORDS 3456
#define XB_SPIN_CAP (1u << 18)

__device__ __forceinline__ unsigned xb_ld(unsigned* p)              { return __hip_atomic_load(p, __ATOMIC_RELAXED, __HIP_MEMORY_SCOPE_AGENT); }
__device__ __forceinline__ unsigned xb_add(unsigned* p, unsigned v) { return __hip_atomic_fetch_add(p, v, __ATOMIC_RELAXED, __HIP_MEMORY_SCOPE_AGENT); }
__device__ __forceinline__ unsigned xb_xcc_id() { return (unsigned)__builtin_amdgcn_s_getreg((3 << 11) | 20) & 0xFu; }
#define XB_SPIN(cond, bar) do { unsigned _sp = 0; while (cond) { __builtin_amdgcn_s_sleep(1); \
    if ((++_sp & 255u) == 0u) { if (xb_ld(&(bar)[XB_TMO])) break; if (_sp > XB_SPIN_CAP) { atomicAdd(&(bar)[XB_TMO], 1u); break; } } } } while (0)

struct XcdBarrier {
    unsigned* bar; unsigned x;
    volatile LAS unsigned* st;
};

__device__ __forceinline__ XcdBarrier xcd_barrier_post(unsigned* bar, volatile LAS unsigned* st) {
    XcdBarrier b; b.bar = bar; b.x = xb_xcc_id(); b.st = st;
    if (threadIdx.x == 0) (void)xb_add(&bar[XB_XCNT(b.x)], 1u);
    return b;
}
__device__ __forceinline__ void xcd_barrier_complete(unsigned* bar, unsigned x, unsigned& nloc, unsigned& nx) {
    const unsigned G = gridDim.x * gridDim.y * gridDim.z;
    unsigned sum, cnt, mine, sp = 0u;
    for (;;) {
        sum = 0u; cnt = 0u; mine = 0u;
#pragma unroll
        for (unsigned j = 0; j < 16; ++j) { const unsigned c = xb_ld(&bar[XB_XCNT(j)]); sum += c; cnt += (c > 0u) ? 1u : 0u; mine = (j == x) ? c : mine; }
        if (sum == G) break;
        __builtin_amdgcn_s_sleep(1);
        if ((++sp & 255u) == 0u) { if (xb_ld(&bar[XB_TMO])) break; if (sp > XB_SPIN_CAP) { atomicAdd(&bar[XB_TMO], 1u); break; } }
    }
    nloc = mine > 0u ? mine : 1u; nx = cnt > 0u ? cnt : 1u;
}

__device__ __forceinline__ void xcd_barrier(const XcdBarrier& b) {
    asm volatile("s_waitcnt vmcnt(0)" ::: "memory");
    __syncthreads();
    if (threadIdx.x == 0) {
        unsigned* bar = b.bar;
        __builtin_amdgcn_s_waitcnt(0);
        unsigned nloc = b.st[0], nx = b.st[1];
        if (nloc == 0u) { xcd_barrier_complete(bar, b.x, nloc, nx); b.st[0] = nloc; b.st[1] = nx; }
        const unsigned old = xb_add(&bar[XB_XSUB(b.x)], 1u);
        const unsigned gen = old / nloc;
        if (old + 1u == (gen + 1u) * nloc) {
            __builtin_amdgcn_fence(__ATOMIC_RELEASE, "agent");
            asm volatile("s_waitcnt vmcnt(0)" ::: "memory");
            const unsigned og = xb_add(&bar[XB_TOP], 1u);
            const unsigned tg = og / nx;
            if (og + 1u == (tg + 1u) * nx) xb_add(&bar[XB_TOPGEN], 1u);
            else XB_SPIN(xb_ld(&bar[XB_TOPGEN]) == tg, bar);
            __builtin_amdgcn_fence(__ATOMIC_ACQUIRE, "agent");
            xb_add(&bar[XB_XGEN(b.x)], 1u);
            asm volatile("s_waitcnt vmcnt(0)" ::: "memory");
        } else {
            XB_SPIN(xb_ld(&bar[XB_XGEN(b.x)]) == gen, bar);
            __builtin_amdgcn_fence(__ATOMIC_ACQUIRE, "agent");
            asm volatile("s_waitcnt vmcnt(0)" ::: "memory");
        }
    }
    __syncthreads();
}

constexpr int N_PHASES = 2 + 6 * DEPTH;
#ifndef REP_MIX
#define REP_MIX 1
#endif
#ifndef FOLD_FLAG
#define FOLD_FLAG 1
#endif
#ifndef WGM_G1
#define WGM_G1 4
#endif
#ifndef WGM_G2
#define WGM_G2 4
#endif
#ifndef WGM_G3
#define WGM_G3 4
#endif
#ifndef WGM_G4
#define WGM_G4 4
#endif
#ifndef REP_A
#define REP_A 1
#endif
#ifndef REP_B
#define REP_B 1
#endif
#ifndef REP_C
#define REP_C 1
#endif
__global__ void __launch_bounds__(512, 2) mega_fwd(Args a) {
    extern __shared__ __attribute__((aligned(16))) unsigned char lds_raw[];
    LAS unsigned char* lds = (LAS unsigned char*)lds_raw;
    cg::grid_group grid = cg::this_grid();
    const int G = gridDim.x, bid = blockIdx.x, NGW = G * 8;
    const int lo = a.ph_lo, hi = a.ph_hi;
    if (lo < 0) grid.sync();
    volatile LAS unsigned* bst = (volatile LAS unsigned*)(lds + LDS_BYTES - 64);
    if (threadIdx.x < 2) bst[threadIdx.x] = 0u;
    __syncthreads();
    XcdBarrier bar = xcd_barrier_post((unsigned*)a.ws, bst);
#define IN(k) (lo <= (k) && (k) < hi)
#define SEAM(k) do { if (IN(k) && IN((k) + 1)) xcd_barrier(bar); } while (0)
    bf16_t* HN = (bf16_t*)(a.ws + WS_HN); bf16_t* Zb = (bf16_t*)(a.ws + WS_Z); bf16_t* MIXb = (bf16_t*)(a.ws + WS_MIX); bf16_t* FFb = (bf16_t*)(a.ws + WS_FF);
    float* X = (float*)(a.ws + WS_X); float* RS = (float*)(a.ws + WS_RS);
    float* Xs = X + (size_t)MPROMPT * DM; bf16_t* HNs = HN + (size_t)MPROMPT * DM;

    if (IN(0)) { phase_prep(a, lds, bid, NGW); phase_rms(a.in[I_XP], a.in[I_XS], a.in[I_NMIX], HN, nullptr, bid, NGW, nullptr, nullptr, RS); }
    SEAM(0);
#ifdef REP_SYNC
    for (int rep = 0; rep < REP_SYNC; ++rep) xcd_barrier(bar);
#endif
#pragma unroll 1
    for (int l = 0; l < DEPTH; ++l) {
        const int p = 1 + 6 * l;
        float* rsA = RS + (size_t)(2 * l) * MV; float* rsF = RS + (size_t)(2 * l + 1) * MV; float* rsN = RS + (size_t)(2 * l + 2) * MV;
        if (IN(p)) {
            const bf16_t* Wt = (const bf16_t*)(a.ws + WS_WIN) + (size_t)l * DM * DIN;
            pg8::Gemm g{HN, Wt, MPROMPT, DIN, DM}; pg8::StaticOrder S; S.init(MPROMPT, DIN, G, bid, WGM_G1);
            pg8::EpiBf16<0> E{Zb, DIN, rsA, 1.0f / DM, EPS};
            unsigned* sflag = (unsigned*)(a.ws + WS_QCTR) + 64 * (8 + l);
            if (FOLD_FLAG && l > 0) sample_fold(a, bid, rsA + MPROMPT, sflag);
            pg8::gemm_phase<pg8::EpiBf16<0>, pg8::StaticOrder, true, true>(lds, g, S, E);
            if (FOLD_FLAG && l > 0) {
                if (threadIdx.x == 0) { unsigned sp = 0; while (__hip_atomic_load(sflag, __ATOMIC_RELAXED, __HIP_MEMORY_SCOPE_AGENT) < (unsigned)NS && ++sp < (1u << 22)) __builtin_amdgcn_s_sleep(2);
                    __builtin_amdgcn_fence(__ATOMIC_ACQUIRE, "agent"); asm volatile("s_waitcnt vmcnt(0)" ::: "memory"); }
                __syncthreads(); }
            skinny_gemm<0, 1>(lds, HNs, Wt, DM, DIN, 1, Zb + (size_t)MPROMPT * DIN, nullptr, nullptr, rsA + MPROMPT, bid, G);
        }
        SEAM(p);
        if (IN(p + 1)) {
            __syncthreads();
            unsigned* qctr = (unsigned*)(a.ws + WS_QCTR) + 64 * (2 * l);
            volatile LAS unsigned* qslot = (volatile LAS unsigned*)(lds + LDS_BYTES - 32);
            unsigned nxt = 0u;
            if (threadIdx.x == 0) nxt = __hip_atomic_fetch_add(qctr, 1u, __ATOMIC_RELAXED, __HIP_MEMORY_SCOPE_AGENT);
            for (;;) {
                if (threadIdx.x == 0) { qslot[0] = nxt; nxt = __hip_atomic_fetch_add(qctr, 1u, __ATOMIC_RELAXED, __HIP_MEMORY_SCOPE_AGENT); }
                __syncthreads();
                const int it = (int)qslot[0];
                __syncthreads();
                if (it >= 520 + 264 + 288) break;
                if (it < 520) { for (int rep = 0; rep < REP_A; ++rep) mixA_item(a, lds, l, it); }
                else if (it < 784) { for (int rep = 0; rep < REP_C; ++rep) mixC_item(a, lds, l, it - 520); }
                else { for (int rep = 0; rep < REP_B; ++rep) mixB_item(a, lds, l, it - 784); }
            }
        }
        SEAM(p + 1);
        if (IN(p + 2)) {
            for (int rep = 0; rep < REP_MIX; ++rep)
            for (int it = bid; it < 512; it += G) mixA2_item(a, lds, l, it);
        }
        SEAM(p + 2);
        if (IN(p + 3)) {
            const bf16_t* Wt = (const bf16_t*)(a.ws + WS_WOUT) + (size_t)l * DM * DM;
            pg8::Gemm g{MIXb, Wt, MPROMPT, DM, DM}; pg8::StaticOrder S; S.init(MPROMPT, DM, G, bid, WGM_G2);
            pg8::EpiResF32 E{l == 0 ? a.in[I_XP] : X, X, DM, HN, rsF};
            pg8::gemm_phase<pg8::EpiResF32, pg8::StaticOrder, true, true>(lds, g, S, E);
            skinny_gemm<3, 1>(lds, MIXb + (size_t)MPROMPT * DM, Wt, DM, DM, 1, HNs, l == 0 ? a.in[I_XS] : Xs, Xs, rsF + MPROMPT, bid, G);
        }
        SEAM(p + 3);
        if (IN(p + 4)) {
            const bf16_t* Wt = (const bf16_t*)(a.ws + WS_WFF1) + (size_t)l * DM * DFF;
            pg8::Gemm g{HN, Wt, MPROMPT, DFF, DM}; pg8::StaticOrder S; S.init(MPROMPT, DFF, G, bid, WGM_G3);
            pg8::EpiBf16<2> E{FFb, DFF, rsF, 1.0f / DM, EPS};
            pg8::gemm_phase<pg8::EpiBf16<2>, pg8::StaticOrder, true, true>(lds, g, S, E);
            skinny_gemm<2, 2>(lds, HNs, Wt, DM, DFF, 1, FFb + (size_t)MPROMPT * DFF, nullptr, nullptr, rsF + MPROMPT, bid, G);
        }
        SEAM(p + 4);
        if (IN(p + 5)) {
            const bf16_t* Wt = (const bf16_t*)(a.ws + WS_WFF2) + (size_t)l * DM * DFF;
            pg8::Gemm g{FFb, Wt, MPROMPT, DM, DFF}; pg8::StaticOrder S; S.init(MPROMPT, DM, G, bid, WGM_G4);
            const bool last = (l + 1 == DEPTH);
            pg8::EpiResF32 E{X, X, DM, last ? nullptr : HN, last ? nullptr : rsN};
            pg8::gemm_phase<pg8::EpiResF32, pg8::StaticOrder, true, true>(lds, g, S, E);
            if (FOLD_FLAG || last) skinny_gemm<4, 4>(lds, FFb + (size_t)MPROMPT * DFF, Wt, DFF, DM, 8, nullptr, nullptr, (float*)(a.ws + WS_PART), nullptr, bid, G);
            else skinny_gemm<3, 2>(lds, FFb + (size_t)MPROMPT * DFF, Wt, DFF, DM, 1, HNs, Xs, Xs, rsN + MPROMPT, bid, G);
        }
        SEAM(p + 5);
    }
    if (IN(1 + 6 * DEPTH)) phase_rms(X, Xs, a.in[I_NFIN], nullptr, a.out + O_YP, bid, NGW, (const float*)(a.ws + WS_PART), Xs);
#undef IN
#undef SEAM
}

#ifndef MK_PER_PHASE
#define MK_PER_PHASE 0
#endif
extern "C" void kernel_launch(void* const* d_in, const int* in_sizes, int n_in, void* d_out, int out_size, void* d_ws, size_t ws_size, hipStream_t stream) {
    static int grid = 0;
    if (grid == 0) {
        if (n_in != N_INPUTS || ws_size < WS_END) { fprintf(stderr, "kernel_launch: unexpected n_in %d / ws %zu\n", n_in, ws_size); grid = -1; return; }
        int dev = 0, cus = 0, per_cu = 0;
        (void)hipGetDevice(&dev); (void)hipDeviceGetAttribute(&cus, hipDeviceAttributeMultiprocessorCount, dev);
        if (hipFuncSetAttribute((const void*)mega_fwd, hipFuncAttributeMaxDynamicSharedMemorySize, LDS_BYTES) != hipSuccess) { fprintf(stderr, "kernel_launch: hipFuncSetAttribute failed\n"); grid = -1; return; }
        if (hipOccupancyMaxActiveBlocksPerMultiprocessor(&per_cu, (const void*)mega_fwd, 512, LDS_BYTES) != hipSuccess || per_cu < 1) per_cu = 1;
        (void)hipGetLastError();
        if (cus <= 0) cus = 256;
        grid = cus * per_cu;
    }
    if (grid < 0) return;
    if (hipMemsetAsync(d_ws, 0, 262144, stream) != hipSuccess) { fprintf(stderr, "kernel_launch: memset failed\n"); return; }
    Args a{};
    for (int i = 0; i < N_INPUTS; ++i) a.in[i] = (const float*)d_in[i];
    a.out = (float*)d_out; a.ws = (unsigned char*)d_ws;
#if MK_PER_PHASE
    for (int p = 0; p < N_PHASES; ++p) { a.ph_lo = p; a.ph_hi = p + 1; hipLaunchKernelGGL(mega_fwd, dim3(grid), dim3(512), LDS_BYTES, stream, a); }
#else
    a.ph_lo = 0; a.ph_hi = N_PHASES;
    void* kargs[] = {&a};
    hipError_t e = hipLaunchCooperativeKernel((const void*)mega_fwd, dim3(grid), dim3(512), kargs, LDS_BYTES, stream);
    if (e != hipSuccess) fprintf(stderr, "cooperative launch failed: %s (grid %d)\n", hipGetErrorString(e), grid);
#endif
}
```
